# Optimizing an MI355X kernel written in HIP

```python
import math
import jax
import jax.numpy as jnp
from jax import lax
import numpy as np

D_MODEL = 1024
BATCH = 16
SEQ = 2048
DEPTH = 2
DEC_BATCH = 128
DEC_SEQ = 1
PAST_LEN = 16384
PAGE_SIZE = 128

N_AB = (DEPTH + 1) // 2
N_C = DEPTH // 2

CONV_WIDTH = 4
GDN_HEADS = 4
GDN_DK = 128
GDN_DV = 128
GDN_CHUNK = 64
GDN_QK_W = GDN_HEADS * GDN_DK
GDN_QKV_W = 2 * GDN_QK_W + GDN_HEADS * GDN_DV
GDN_V_W = GDN_HEADS * GDN_DV
LRU_WIDTH = D_MODEL // 2
LRU_BLOCKS = 8
LRU_BW = LRU_WIDTH // LRU_BLOCKS
LRU_C = 8.0
AB_IN_W = GDN_QKV_W + GDN_V_W + 2 * GDN_HEADS + 2 * LRU_WIDTH
AB_MIX_W = GDN_V_W + LRU_WIDTH
SWA_HEADS = 16
SWA_KV_HEADS = 4
SWA_GROUP = SWA_HEADS // SWA_KV_HEADS
SWA_HEAD_DIM = 64
WINDOW = 128
SWA_KV_W = SWA_KV_HEADS * SWA_HEAD_DIM
SWA_OUT_W = SWA_HEADS * SWA_HEAD_DIM
SWA_QKV_W = SWA_OUT_W + 2 * SWA_KV_W
D_FF = -(-8 * D_MODEL // (3 * 256)) * 256
NORM_EPS = 1e-6

kernel_name = 'hybrid_gdn_rglru_swa_decoder_step'


def rmsnorm(x, w):
    xf = x.astype(jnp.float32)
    y = xf * lax.rsqrt(jnp.mean(xf * xf, axis=-1, keepdims=True) + NORM_EPS)
    return (y * w.astype(jnp.float32)).astype(x.dtype)


def l2norm(x):
    return x * lax.rsqrt(jnp.sum(x * x, axis=-1, keepdims=True) + NORM_EPS)


def causal_conv(x, buf, w, b=None):
    xp = jnp.concatenate([buf.astype(x.dtype), x], axis=1)
    y = lax.conv_general_dilated(xp, w[:, None, :].astype(x.dtype), window_strides=(1,), padding='VALID',
                                 dimension_numbers=('NWC', 'WIO', 'NWC'), feature_group_count=x.shape[-1])
    if b is not None:
        y = y + b.astype(x.dtype)
    return y, xp[:, xp.shape[1] - (CONV_WIDTH - 1):]


def gdn_chunked(q, k, v, beta, g, s0):
    bsz, t, h, dk = q.shape
    dv = v.shape[-1]
    c = GDN_CHUNK
    n = t // c

    def blk(a):
        return jnp.moveaxis(a.reshape((bsz, n, c, h) + a.shape[3:]), 3, 1)

    q, k, v, beta, g = blk(q), blk(k), blk(v), blk(beta), blk(g)
    gam = jnp.cumsum(g, axis=-1)
    causal = jnp.tril(jnp.ones((c, c), dtype=bool))
    strict = jnp.tril(jnp.ones((c, c), dtype=bool), -1)
    decay = jnp.exp(jnp.where(causal, gam[..., :, None] - gam[..., None, :], -jnp.inf))
    kk = jnp.einsum('bhnid,bhnjd->bhnij', k, k)
    a_mat = jnp.where(strict, beta[..., None] * kk * decay, 0.0) + jnp.eye(c, dtype=q.dtype)
    rhs = jnp.concatenate([beta[..., None] * v, (beta * jnp.exp(gam))[..., None] * k], axis=-1)
    sol = lax.linalg.triangular_solve(a_mat, rhs, left_side=True, lower=True, unit_diagonal=True)
    w_val, w_key = sol[..., :dv], sol[..., dv:]
    qk = jnp.einsum('bhnid,bhnjd->bhnij', q, k) * decay
    q_dec = q * jnp.exp(gam)[..., None]
    k_tail = k * jnp.exp(gam[..., -1:] - gam)[..., None]
    g_tot = jnp.exp(gam[..., -1])

    def step(s, xs):
        wv, wk, qkn, qd, kt, gt = xs
        u = wv - jnp.einsum('bhcd,bhde->bhce', wk, s)
        o = jnp.einsum('bhcd,bhde->bhce', qd, s) + jnp.einsum('bhcj,bhje->bhce', qkn, u)
        s = s * gt[..., None, None] + jnp.einsum('bhcd,bhce->bhde', kt, u)
        return s, o

    xs = tuple(jnp.moveaxis(a, 2, 0) for a in (w_val, w_key, qk, q_dec, k_tail, g_tot))
    s_fin, o = lax.scan(step, s0, xs)
    o = jnp.transpose(o, (1, 0, 3, 2, 4)).reshape(bsz, t, h, dv)
    return o, s_fin


def gdn_stepwise(q, k, v, beta, g, s0):
    def step(s, xs):
        qt, kt, vt, bt, gt = xs
        s = s * jnp.exp(gt)[..., None, None]
        pred = jnp.einsum('bhd,bhde->bhe', kt, s)
        s = s + jnp.einsum('bhd,bhe->bhde', kt, bt[..., None] * (vt - pred))
        return s, jnp.einsum('bhd,bhde->bhe', qt, s)

    xs = tuple(jnp.swapaxes(a, 0, 1) for a in (q, k, v, beta, g))
    s_fin, o = lax.scan(step, s0, xs)
    return jnp.swapaxes(o, 0, 1), s_fin


def rglru(x, h0, wa, ba, wx, bx, lam):
    bsz, t, w = x.shape
    xb = x.reshape(bsz, t, LRU_BLOCKS, LRU_BW)
    r = jax.nn.sigmoid(jnp.einsum('btni,nij->btnj', xb, wa).reshape(bsz, t, w) + ba)
    i = jax.nn.sigmoid(jnp.einsum('btni,nij->btnj', xb, wx).reshape(bsz, t, w) + bx)
    log_a = -LRU_C * r * jax.nn.softplus(-lam)
    a = jnp.exp(log_a)
    b = jnp.sqrt(-jnp.expm1(2.0 * log_a)) * (i * x)

    def comb(lhs, rhs):
        return lhs[0] * rhs[0], rhs[0] * lhs[1] + rhs[1]

    a_cum, hs = lax.associative_scan(comb, (a, b), axis=1)
    hs = hs + a_cum * h0[:, None, :]
    return hs, hs[:, -1]


def mixer_ab(hn, w_in, conv_gdn_w, a_log, dt_bias, gdn_norm_w, conv_lru_w, conv_lru_b, lru_wa, lru_ba,
             lru_wx, lru_bx, lru_lambda, w_out, s0, gdn_buf, h0, lru_buf, chunked):
    f32 = jnp.float32
    bsz, t, _ = hn.shape
    c1 = GDN_QKV_W
    c2 = c1 + GDN_V_W
    c3 = c2 + GDN_HEADS
    c4 = c3 + GDN_HEADS
    c5 = c4 + LRU_WIDTH
    proj = hn @ w_in
    qkv, z, b_in, a_in, gate_in, xr_in = jnp.split(proj, [c1, c2, c3, c4, c5], axis=-1)
    qkv, gdn_buf_new = causal_conv(qkv, gdn_buf, conv_gdn_w)
    qkv = jax.nn.silu(qkv).astype(f32)
    q = l2norm(qkv[..., :GDN_QK_W].reshape(bsz, t, GDN_HEADS, GDN_DK)) * GDN_DK ** -0.5
    k = l2norm(qkv[..., GDN_QK_W:2 * GDN_QK_W].reshape(bsz, t, GDN_HEADS, GDN_DK))
    v = qkv[..., 2 * GDN_QK_W:].reshape(bsz, t, GDN_HEADS, GDN_DV)
    beta = jax.nn.sigmoid(b_in.astype(f32))
    g = -jnp.exp(a_log.astype(f32)) * jax.nn.softplus(a_in.astype(f32) + dt_bias.astype(f32))
    core = gdn_chunked if chunked else gdn_stepwise
    o, s_new = core(q, k, v, beta, g, s0.astype(f32))
    o = o * lax.rsqrt(jnp.mean(o * o, axis=-1, keepdims=True) + NORM_EPS) * gdn_norm_w.astype(f32)
    o = o * jax.nn.silu(z.astype(f32).reshape(bsz, t, GDN_HEADS, GDN_DV))
    o = o.reshape(bsz, t, GDN_V_W).astype(hn.dtype)
    xr, lru_buf_new = causal_conv(xr_in, lru_buf, conv_lru_w, conv_lru_b)
    hs, h_new = rglru(xr.astype(f32), h0.astype(f32), lru_wa.astype(f32), lru_ba.astype(f32),
                      lru_wx.astype(f32), lru_bx.astype(f32), lru_lambda.astype(f32))
    y_lru = jax.nn.gelu(gate_in) * hs.astype(hn.dtype)
    out = jnp.concatenate([o, y_lru], axis=-1) @ w_out
    return out, s_new.astype(hn.dtype), gdn_buf_new, h_new.astype(hn.dtype), lru_buf_new


def alibi_slopes():
    return jnp.exp2(-8.0 * jnp.arange(1, SWA_HEADS + 1, dtype=jnp.float32) / SWA_HEADS)


def window_attend(qg, kk, vv, rel, keep, sinks, slopes):
    f32 = jnp.float32
    s = jnp.einsum('bqhgd,bkhd->bhgqk', qg, kk).astype(f32) * SWA_HEAD_DIM ** -0.5
    s = s - slopes.reshape(SWA_KV_HEADS, SWA_GROUP, 1, 1) * rel.astype(f32)
    s = jnp.where(keep, s, -jnp.inf)
    sink = sinks.astype(f32).reshape(SWA_KV_HEADS, SWA_GROUP, 1, 1)
    m = jnp.maximum(jnp.max(s, axis=-1, keepdims=True), sink)
    p = jnp.exp(s - m)
    p = p / (jnp.sum(p, axis=-1, keepdims=True) + jnp.exp(sink - m))
    return jnp.einsum('bhgqk,bkhd->bqhgd', p.astype(vv.dtype), vv)


def mixer_c(hn, w_qkv, w_out, sinks, k_buf, v_buf):
    bsz, t, _ = hn.shape
    qkv = hn @ w_qkv
    q = qkv[..., :SWA_OUT_W].reshape(bsz, t, SWA_KV_HEADS, SWA_GROUP, SWA_HEAD_DIM)
    k = qkv[..., SWA_OUT_W:SWA_OUT_W + SWA_KV_W].reshape(bsz, t, SWA_KV_HEADS, SWA_HEAD_DIM)
    v = qkv[..., SWA_OUT_W + SWA_KV_W:].reshape(bsz, t, SWA_KV_HEADS, SWA_HEAD_DIM)
    slopes = alibi_slopes()
    if k_buf is None:
        nb = t // WINDOW
        qb = jnp.moveaxis(q.reshape(bsz, nb, WINDOW, SWA_KV_HEADS, SWA_GROUP, SWA_HEAD_DIM), 1, 0)

        def band(a):
            ab = jnp.moveaxis(a.reshape(bsz, nb, WINDOW, SWA_KV_HEADS, SWA_HEAD_DIM), 1, 0)
            prev = jnp.concatenate([jnp.zeros_like(ab[:1]), ab[:-1]], axis=0)
            return jnp.concatenate([prev, ab], axis=2)

        kb, vb = band(k), band(v)
        kj = jnp.arange(2 * WINDOW)[None, :]
        rel = jnp.arange(WINDOW)[:, None] + WINDOW - kj
        in_band = (rel >= 0) & (rel <= WINDOW)

        def one_block(args):
            qn, kn, vn, n = args
            keep = in_band & (n * WINDOW + kj - WINDOW >= 0)
            return window_attend(qn, kn, vn, rel, keep, sinks, slopes)

        o = lax.map(one_block, (qb, kb, vb, jnp.arange(nb)))
        o = jnp.moveaxis(o, 0, 1).reshape(bsz, t, SWA_OUT_W)
        k_new, v_new = k[:, t - WINDOW:], v[:, t - WINDOW:]
    else:
        lb = k_buf.shape[1]
        kk = jnp.concatenate([k_buf.astype(k.dtype), k], axis=1)
        vv = jnp.concatenate([v_buf.astype(v.dtype), v], axis=1)
        rel = (lb + jnp.arange(t))[:, None] - jnp.arange(lb + t)[None, :]
        keep = (rel >= 0) & (rel <= WINDOW)
        o = window_attend(q, kk, vv, rel, keep, sinks, slopes).reshape(bsz, t, SWA_OUT_W)
        k_new, v_new = kk[:, t:], vv[:, t:]
    return o @ w_out, k_new, v_new


def swiglu(hn, w_gate_up, w_down):
    gu = hn @ w_gate_up
    return (jax.nn.silu(gu[..., :D_FF]) * gu[..., D_FF:]) @ w_down


def run_trunk(x, gdn_s, gdn_cb, lru_h, lru_cb, swa_k, swa_v, prm, is_prompt):
    n_s, n_gcb, n_h, n_lcb, n_k, n_v = [], [], [], [], [], []
    ia = 0
    ic = 0
    for layer in range(DEPTH):
        hn = rmsnorm(x, prm['norm_mix'][layer])
        if layer % 2 == 0:
            out, s_new, gcb, h_new, lcb = mixer_ab(
                hn, prm['w_in_ab'][ia], prm['conv_gdn_w'][ia], prm['gdn_a_log'][ia], prm['gdn_dt_bias'][ia],
                prm['gdn_norm_w'][ia], prm['conv_lru_w'][ia], prm['conv_lru_b'][ia], prm['lru_wa'][ia],
                prm['lru_ba'][ia], prm['lru_wx'][ia], prm['lru_bx'][ia], prm['lru_lambda'][ia], prm['w_out_ab'][ia],
                gdn_s[ia], gdn_cb[ia], lru_h[ia], lru_cb[ia], is_prompt)
            n_s.append(s_new)
            n_gcb.append(gcb)
            n_h.append(h_new)
            n_lcb.append(lcb)
            ia += 1
        else:
            kb = None if is_prompt else swa_k[ic]
            vb = None if is_prompt else swa_v[ic]
            out, k_new, v_new = mixer_c(hn, prm['w_qkv_c'][ic], prm['w_out_c'][ic], prm['sinks_c'][ic], kb, vb)
            n_k.append(k_new)
            n_v.append(v_new)
            ic += 1
        x = x + out
        x = x + swiglu(rmsnorm(x, prm['norm_ffn'][layer]), prm['w_gate_up'][layer], prm['w_down'][layer])
    y = rmsnorm(x, prm['norm_final'])
    return (y, jnp.stack(n_s), jnp.stack(n_gcb), jnp.stack(n_h), jnp.stack(n_lcb),
            jnp.stack(n_k), jnp.stack(n_v))


def setup_inputs(seed: int = 0) -> dict:
    key = jax.random.key(seed)
    sub = jax.random.split(key, 32)
    idx = list(range(32))
    f32 = jnp.float32

    def nk():
        return sub[idx.pop()]

    def nrm(shape, scale):
        return jax.random.normal(nk(), shape, f32) * scale

    def gain(shape):
        return 1.0 + nrm(shape, 0.02)

    lb = min(WINDOW, PAST_LEN)
    dt = jnp.exp(jax.random.uniform(nk(), (N_AB, GDN_HEADS), f32, math.log(1e-3), math.log(1e-1)))
    a_pow = jax.random.uniform(nk(), (N_AB, LRU_WIDTH), f32, 0.9, 0.999)
    a_base = a_pow ** (1.0 / LRU_C)
    return {
        'x_prompt': nrm((BATCH, SEQ, D_MODEL), 1.0),
        'x_sample': nrm((DEC_BATCH, DEC_SEQ, D_MODEL), 1.0),
        'state_gdn': nrm((N_AB, DEC_BATCH, GDN_HEADS, GDN_DK, GDN_DV), 0.3),
        'state_gdn_conv': nrm((N_AB, DEC_BATCH, CONV_WIDTH - 1, GDN_QKV_W), 1.0),
        'state_lru': nrm((N_AB, DEC_BATCH, LRU_WIDTH), 0.5),
        'state_lru_conv': nrm((N_AB, DEC_BATCH, CONV_WIDTH - 1, LRU_WIDTH), 1.0),
        'cache_swa_k': nrm((N_C, DEC_BATCH, lb, SWA_KV_HEADS, SWA_HEAD_DIM), 1.0),
        'cache_swa_v': nrm((N_C, DEC_BATCH, lb, SWA_KV_HEADS, SWA_HEAD_DIM), 1.0),
        'norm_mix': gain((DEPTH, D_MODEL)),
        'norm_ffn': gain((DEPTH, D_MODEL)),
        'norm_final': gain((D_MODEL,)),
        'w_in_ab': nrm((N_AB, D_MODEL, AB_IN_W), D_MODEL ** -0.5),
        'conv_gdn_w': nrm((N_AB, CONV_WIDTH, GDN_QKV_W), CONV_WIDTH ** -0.5),
        'gdn_a_log': jnp.log(jax.random.uniform(nk(), (N_AB, GDN_HEADS), f32, 1.0, 16.0)),
        'gdn_dt_bias': dt + jnp.log(-jnp.expm1(-dt)),
        'gdn_norm_w': gain((N_AB, GDN_DV)),
        'conv_lru_w': nrm((N_AB, CONV_WIDTH, LRU_WIDTH), CONV_WIDTH ** -0.5),
        'conv_lru_b': nrm((N_AB, LRU_WIDTH), 0.02),
        'lru_wa': nrm((N_AB, LRU_BLOCKS, LRU_BW, LRU_BW), LRU_BW ** -0.5),
        'lru_ba': nrm((N_AB, LRU_WIDTH), 0.02),
        'lru_wx': nrm((N_AB, LRU_BLOCKS, LRU_BW, LRU_BW), LRU_BW ** -0.5),
        'lru_bx': nrm((N_AB, LRU_WIDTH), 0.02),
        'lru_lambda': jnp.log(a_base) - jnp.log1p(-a_base),
        'w_out_ab': nrm((N_AB, AB_MIX_W, D_MODEL), AB_MIX_W ** -0.5),
        'w_qkv_c': nrm((N_C, D_MODEL, SWA_QKV_W), D_MODEL ** -0.5),
        'w_out_c': nrm((N_C, SWA_OUT_W, D_MODEL), SWA_OUT_W ** -0.5),
        'sinks_c': nrm((N_C, SWA_HEADS), 1.0),
        'w_gate_up': nrm((DEPTH, D_MODEL, 2 * D_FF), D_MODEL ** -0.5),
        'w_down': nrm((DEPTH, D_FF, D_MODEL), D_FF ** -0.5),
    }


def reference(x_prompt, x_sample, state_gdn, state_gdn_conv, state_lru, state_lru_conv, cache_swa_k, cache_swa_v,
              norm_mix, norm_ffn, norm_final, w_in_ab, conv_gdn_w, gdn_a_log, gdn_dt_bias, gdn_norm_w,
              conv_lru_w, conv_lru_b, lru_wa, lru_ba, lru_wx, lru_bx, lru_lambda, w_out_ab, w_qkv_c, w_out_c,
              sinks_c, w_gate_up, w_down):
    prm = dict(norm_mix=norm_mix, norm_ffn=norm_ffn, norm_final=norm_final, w_in_ab=w_in_ab,
               conv_gdn_w=conv_gdn_w, gdn_a_log=gdn_a_log, gdn_dt_bias=gdn_dt_bias, gdn_norm_w=gdn_norm_w,
               conv_lru_w=conv_lru_w, conv_lru_b=conv_lru_b, lru_wa=lru_wa, lru_ba=lru_ba, lru_wx=lru_wx,
               lru_bx=lru_bx, lru_lambda=lru_lambda, w_out_ab=w_out_ab, w_qkv_c=w_qkv_c, w_out_c=w_out_c,
               sinks_c=sinks_c, w_gate_up=w_gate_up, w_down=w_down)
    bp = x_prompt.shape[0]
    dt = x_prompt.dtype
    z_s = jnp.zeros((N_AB, bp, GDN_HEADS, GDN_DK, GDN_DV), dt)
    z_gcb = jnp.zeros((N_AB, bp, CONV_WIDTH - 1, GDN_QKV_W), dt)
    z_h = jnp.zeros((N_AB, bp, LRU_WIDTH), dt)
    z_lcb = jnp.zeros((N_AB, bp, CONV_WIDTH - 1, LRU_WIDTH), dt)
    y_prompt, p_gdn, p_gdn_conv, p_lru, p_lru_conv, p_swa_k, p_swa_v = run_trunk(
        x_prompt, z_s, z_gcb, z_h, z_lcb, None, None, prm, True)
    y_sample, s_gdn, s_gdn_conv, s_lru, s_lru_conv, s_swa_k, s_swa_v = run_trunk(
        x_sample, state_gdn, state_gdn_conv, state_lru, state_lru_conv, cache_swa_k, cache_swa_v, prm, False)
    return (y_prompt, y_sample, p_gdn, p_gdn_conv, p_lru, p_lru_conv, p_swa_k, p_swa_v,
            s_gdn, s_gdn_conv, s_lru, s_lru_conv, s_swa_k, s_swa_v)
```

```cpp
#include <hip/hip_runtime.h>
#include <cstdio>
#include <cstdint>

#define DI __device__ __forceinline__
#define LAS __attribute__((address_space(3)))
typedef unsigned short bf16_t;
typedef short bf16x8 __attribute__((ext_vector_type(8)));
typedef short bf16x4 __attribute__((ext_vector_type(4)));
typedef float f32x2 __attribute__((ext_vector_type(2)));
typedef float f32x4 __attribute__((ext_vector_type(4)));
typedef float f32x16 __attribute__((ext_vector_type(16)));
typedef unsigned u32x2 __attribute__((ext_vector_type(2)));
typedef unsigned u32x4 __attribute__((ext_vector_type(4)));
typedef __bf16 bf16v2 __attribute__((ext_vector_type(2)));

DI unsigned pk2(float a, float b) { bf16v2 v = {(__bf16)a, (__bf16)b}; return __builtin_bit_cast(unsigned, v); }
DI bf16_t f2bf(float a) { __bf16 v = (__bf16)a; return __builtin_bit_cast(bf16_t, v); }
DI float bf2f(unsigned h) { return __uint_as_float(h << 16); }
DI float bflo(unsigned w) { return __uint_as_float(w << 16); }
DI float bfhi(unsigned w) { return __uint_as_float(w & 0xffff0000u); }
DI float wave_sum(float v) {
#pragma unroll
    for (int o = 1; o < 64; o <<= 1) v += __shfl_xor(v, o);
    return v;
}
DI float sigmoidf_(float x) { return __builtin_amdgcn_rcpf(1.f + __expf(-x)); }
DI float siluf_(float x) { return x * __builtin_amdgcn_rcpf(1.f + __expf(-x)); }
DI float softplusf_(float x) { return fmaxf(x, 0.f) + log1pf(__expf(-fabsf(x))); }
DI float gelu_tanh(float x) { const float u = 0.7978845608028654f * (x + 0.044715f * x * x * x); return x * __builtin_amdgcn_rcpf(1.f + __expf(-2.0f * u)); }
#define BAR_LDS() do { asm volatile("s_waitcnt lgkmcnt(0)" ::: "memory"); __builtin_amdgcn_s_barrier(); asm volatile("" ::: "memory"); } while (0)

constexpr int D = 1024, TSEQ = 2048, NBATCH = 16, MP = NBATCH * TSEQ, NS = 128, MREAL = MP + NS, MPAD = 33024;
constexpr int NIN = 3072, FF = 2816, NGU = 2 * FF, NQKV = 1536;
constexpr float EPS = 1e-6f;
constexpr int NCHUNK = 32;
constexpr int NCHUNKS = NBATCH * 4 * NCHUNK;

constexpr size_t O_Y = 0;
constexpr size_t O_PGDN = (size_t)MREAL * D;
constexpr size_t O_PGDNCONV = O_PGDN + (size_t)16 * 4 * 128 * 128;
constexpr size_t O_PLRU = O_PGDNCONV + (size_t)16 * 3 * 1536;
constexpr size_t O_PLRUCONV = O_PLRU + (size_t)16 * 512;
constexpr size_t O_PSWAK = O_PLRUCONV + (size_t)16 * 3 * 512;
constexpr size_t O_PSWAV = O_PSWAK + (size_t)16 * 128 * 256;
constexpr size_t O_SGDN = O_PSWAV + (size_t)16 * 128 * 256;
constexpr size_t O_SGDNCONV = O_SGDN + (size_t)128 * 4 * 128 * 128;
constexpr size_t O_SLRU = O_SGDNCONV + (size_t)128 * 3 * 1536;
constexpr size_t O_SLRUCONV = O_SLRU + (size_t)128 * 512;
constexpr size_t O_SSWAK = O_SLRUCONV + (size_t)128 * 3 * 512;
constexpr size_t O_SSWAV = O_SSWAK + (size_t)128 * 128 * 256;
constexpr size_t O_END = O_SSWAV + (size_t)128 * 128 * 256;
static_assert(O_END == 53518336, "output size");

constexpr size_t MiB = 1u << 20;
constexpr size_t WS_CTL = 0, CTL_BYTES = 65536;
constexpr size_t WS_SS = 1 * MiB;
constexpr size_t SS_STRIDE = (size_t)MPAD * 4;
constexpr size_t WS_BA = 2 * MiB;
constexpr size_t WS_GT = WS_BA + (size_t)MPAD * 8 * 4;
constexpr size_t WS_W = 4 * MiB;
constexpr size_t W_IN = 0, W_OUTAB = W_IN + (size_t)NIN * D, W_GU0 = W_OUTAB + (size_t)D * D, W_GU1 = W_GU0 + (size_t)NGU * D,
                 W_DN0 = W_GU1 + (size_t)NGU * D, W_DN1 = W_DN0 + (size_t)D * FF, W_QKV = W_DN1 + (size_t)D * FF, W_OUTC = W_QKV + (size_t)NQKV * D,
                 W_END = W_OUTC + (size_t)D * D;
static_assert(W_END * 2 <= 50 * MiB, "weights");
constexpr size_t WS_BIG = 54 * MiB;
constexpr size_t BIG_BYTES = (size_t)MPAD * NIN * 2;
constexpr size_t WS_MIX = 250 * MiB;
constexpr size_t WS_XB = 316 * MiB;
constexpr size_t WS_GDNI = WS_XB;
constexpr size_t GDNI_STG = 57344;
constexpr size_t WS_GDNWV = WS_GDNI + (size_t)NCHUNKS * GDNI_STG;
constexpr size_t WS_ZS = WS_GDNWV + (size_t)NCHUNKS * 16384;
constexpr size_t WS_END = WS_ZS + (size_t)NCHUNKS * 16384;
static_assert(WS_BIG + BIG_BYTES <= WS_MIX && WS_MIX + (size_t)MPAD * D * 2 <= WS_XB && WS_END <= 492 * MiB, "ws map");

constexpr int LDS_MISC = 160 * 1024 - 256;
constexpr int LDS_BYTES = 160 * 1024;

#define XB_TMO      128
#define XB_XCNT(j)  (256  + 64 * (j))
#define XB_XSUB(j)  (1280 + 64 * (j))
#define XB_XGEN(j)  (2304 + 64 * (j))
#define XB_TOP      3328
#define XB_TOPGEN   3392
#define XCD_BAR_WORDS 3456
#define XB_SPIN_CAP (1u << 20)
DI unsigned xb_ld(unsigned* p)              { return __hip_atomic_load(p, __ATOMIC_RELAXED, __HIP_MEMORY_SCOPE_AGENT); }
DI unsigned xb_add(unsigned* p, unsigned v) { return __hip_atomic_fetch_add(p, v, __ATOMIC_RELAXED, __HIP_MEMORY_SCOPE_AGENT); }
DI unsigned xb_xcc_id() { return (unsigned)__builtin_amdgcn_s_getreg((3 << 11) | 20) & 0xFu; }
#define XB_SPIN(cond, bar) do { unsigned _sp = 0; while (cond) { __builtin_amdgcn_s_sleep(1); \
    if ((++_sp & 255u) == 0u) { if (xb_ld(&(bar)[XB_TMO])) break; if (_sp > XB_SPIN_CAP) { atomicAdd(&(bar)[XB_TMO], 1u); break; } } } } while (0)
struct XcdBarrier { unsigned* bar; unsigned x; volatile LAS unsigned* st; };
DI XcdBarrier xcd_barrier_post(unsigned* bar, volatile LAS unsigned* st) {
    XcdBarrier b; b.bar = bar; b.x = xb_xcc_id(); b.st = st;
    if (threadIdx.x == 0) (void)xb_add(&bar[XB_XCNT(b.x)], 1u);
    return b;
}
DI void xcd_barrier_complete(unsigned* bar, unsigned x, unsigned& nloc, unsigned& nx) {
    const unsigned G = gridDim.x;
    unsigned sum, cnt, mine, sp = 0u;
    for (;;) {
        sum = 0u; cnt = 0u; mine = 0u;
#pragma unroll
        for (unsigned j = 0; j < 16; ++j) { const unsigned c = xb_ld(&bar[XB_XCNT(j)]); sum += c; cnt += (c > 0u) ? 1u : 0u; mine = (j == x) ? c : mine; }
        if (sum == G) break;
        __builtin_amdgcn_s_sleep(1);
        if ((++sp & 255u) == 0u) { if (xb_ld(&bar[XB_TMO])) break; if (sp > XB_SPIN_CAP) { atomicAdd(&bar[XB_TMO], 1u); break; } }
    }
    nloc = mine > 0u ? mine : 1u; nx = cnt > 0u ? cnt : 1u;
}
DI void xcd_barrier(const XcdBarrier& b) {
    asm volatile("s_waitcnt vmcnt(0)" ::: "memory");
    __syncthreads();
    if (threadIdx.x == 0) {
        unsigned* bar = b.bar;
        __builtin_amdgcn_s_waitcnt(0);
        unsigned nloc = b.st[0], nx = b.st[1];
        if (nloc == 0u) { xcd_barrier_complete(bar, b.x, nloc, nx); b.st[0] = nloc; b.st[1] = nx; }
        const unsigned old = xb_add(&bar[XB_XSUB(b.x)], 1u);
        const unsigned gen = old / nloc;
        if (old + 1u == (gen + 1u) * nloc) {
            __builtin_amdgcn_fence(__ATOMIC_RELEASE, "agent");
            asm volatile("s_waitcnt vmcnt(0)" ::: "memory");
            const unsigned og = xb_add(&bar[XB_TOP], 1u);
            const unsigned tg = og / nx;
            if (og + 1u == (tg + 1u) * nx) xb_add(&bar[XB_TOPGEN], 1u);
            else XB_SPIN(xb_ld(&bar[XB_TOPGEN]) == tg, bar);
            __builtin_amdgcn_fence(__ATOMIC_ACQUIRE, "agent");
            xb_add(&bar[XB_XGEN(b.x)], 1u);
            asm volatile("s_waitcnt vmcnt(0)" ::: "memory");
        } else {
            XB_SPIN(xb_ld(&bar[XB_XGEN(b.x)]) == gen, bar);
            __builtin_amdgcn_fence(__ATOMIC_ACQUIRE, "agent");
            asm volatile("s_waitcnt vmcnt(0)" ::: "memory");
        }
    }
    __syncthreads();
}

struct Params { const float* in[29]; float* out; unsigned char* ws; int ph_lo, ph_hi; };
static_assert(sizeof(Params) == 29 * 8 + 16 + 8, "Params has no padding");
enum { I_XP = 0, I_XS, I_SGDN, I_SGDNCONV, I_SLRU, I_SLRUCONV, I_CK, I_CV, I_NMIX, I_NFFN, I_NFIN, I_WIN, I_CONVG, I_ALOG, I_DTB, I_GNW,
       I_CONVL, I_CONVLB, I_LWA, I_LBA, I_LWX, I_LBX, I_LLAM, I_WOUTAB, I_WQKV, I_WOUTC, I_SINKS, I_WGU, I_WDN };
#ifndef PG8_NT
#define PG8_NT 0
#endif
#if PG8_NT == 1
#define PG8_ST(p_, v_) __builtin_nontemporal_store((v_), (p_))
#else
#define PG8_ST(p_, v_) (*(p_) = (v_))
#endif
#if PG8_NT >= 1
#define PG8_STH(p_, v_) __builtin_nontemporal_store((v_), (p_))
#else
#define PG8_STH(p_, v_) (*(p_) = (v_))
#endif
#ifndef PG8_WGN
#define PG8_WGN 4
#endif
#ifndef PG8_BSTAT
#define PG8_BSTAT 1
#endif
#ifndef PG8_SP2
#define PG8_SP2 1
#endif
#ifndef PG8_ALIGN_EPI
#define PG8_ALIGN_EPI 1
#endif
namespace pg8 {
constexpr int BM = 256, BK = 64, HALF = 128, HTB = HALF * BK * 2, STAGE_BYTES = 8 * HTB, NXCD = 8, WGM = 8;
DI int lds_byte(int r, int c) { const int st = (r >> 4) * 2 + (c >> 5), rr = r & 15, cc = c & 31, ob = rr * 64 + cc * 2; return st * 1024 + (ob ^ (((ob >> 9) & 1) << 5)); }
DI void stage_rc(int b, int& R, int& C) { const int st = b / 1024, sb = b % 1024, swz = sb ^ (((sb >> 9) & 1) << 5); R = (st >> 1) * 16 + swz / 64; C = (st & 1) * 32 + (swz % 64) / 2; }
DI int perm32(int rho) { const int n = rho >> 4, i = rho & 15; return 8 * (i >> 2) + 4 * n + (i & 3); }
struct Unit { int pm, pn; };
struct Gemm { const bf16_t* A; const bf16_t* Bt; int M, N, K; };
struct StaticOrder {
    int nM, nN, nwg, G, c;
    DI void init(int M, int N, int G_, int c_) { nM = M / BM; nN = N / BM; nwg = nM * nN; G = G_; c = c_; }
    DI bool next(int i, Unit& u) const {
        const long L = (long)i * G + c; if (L >= nwg) return false;
        int wgid = (int)L; { const int q = nwg / NXCD, r = nwg % NXCD, xcd = wgid % NXCD, off = wgid / NXCD; wgid = (xcd < r ? xcd * (q + 1) : r * (q + 1) + (xcd - r) * q) + off; }
#if PG8_BSTAT
        const int nig = PG8_WGN * nM, gid = wgid / nig, fn = gid * PG8_WGN, gsz = (nN - fn) < PG8_WGN ? (nN - fn) : PG8_WGN;
        u.pn = fn + ((wgid % nig) % gsz); u.pm = (wgid % nig) / gsz; return true;
#else
        const int nig = WGM * nN, gid = wgid / nig, fm = gid * WGM, gsz = (nM - fm) < WGM ? (nM - fm) : WGM;
        u.pm = fm + ((wgid % nig) % gsz); u.pn = (wgid % nig) / gsz; return true;
#endif
    }
};

struct EpiScaleBf16 {
    static constexpr bool PERM = true;
    bf16_t* O; int ldc; const float* ss; int dry;
    DI void prefetch(float (&pre)[8], const Unit& u, int wr, int fr) const {
#pragma unroll
        for (int k = 0; k < 8; ++k) pre[k] = ss[u.pm * BM + wr * 64 + fr + (k >> 2) * HALF + (k & 3) * 16];
    }
    DI void operator()(const f32x4 (&acc)[2][2][4][2], const Unit& u, int wr, int wc, int fr, int fq, const float (&pre)[8]) const {
        const int row0 = u.pm * BM + wr * 64 + fr, col0 = u.pn * BM + wc * 32 + 8 * fq;
#pragma unroll
        for (int ai = 0; ai < 2; ++ai)
#pragma unroll
            for (int m = 0; m < 4; ++m) {
                const int r = row0 + ai * HALF + m * 16;
                const float rs = rsqrtf(pre[ai * 4 + m] * (1.0f / 1024.0f) + EPS);
                bf16_t* rowp = O + (size_t)r * ldc + col0;
#pragma unroll
                for (int bj = 0; bj < 2; ++bj) {
                    const f32x4 v0 = acc[ai][bj][m][0] * rs, v1 = acc[ai][bj][m][1] * rs;
                    u32x4 w; w.x = pk2(v0[0], v0[1]); w.y = pk2(v0[2], v0[3]); w.z = pk2(v1[0], v1[1]); w.w = pk2(v1[2], v1[3]);
                    if (!dry) PG8_ST((u32x4*)(rowp + bj * HALF), w); else if (w.x == 0x12345679u && w.y == 0x2468ace1u) *(u32x4*)(rowp + bj * HALF) = w;
                }
            }
    }
};
struct EpiSwiglu {
    static constexpr bool PERM = true;
    bf16_t* H; const float* ss;
    DI void prefetch(float (&pre)[8], const Unit& u, int wr, int fr) const {
#pragma unroll
        for (int k = 0; k < 8; ++k) pre[k] = ss[u.pm * BM + wr * 64 + fr + (k >> 2) * HALF + (k & 3) * 16];
    }
    DI void operator()(const f32x4 (&acc)[2][2][4][2], const Unit& u, int wr, int wc, int fr, int fq, const float (&pre)[8]) const {
        const int row0 = u.pm * BM + wr * 64 + fr, col0 = u.pn * HALF + wc * 32 + 8 * fq;
#pragma unroll
        for (int ai = 0; ai < 2; ++ai)
#pragma unroll
            for (int m = 0; m < 4; ++m) {
                const int r = row0 + ai * HALF + m * 16;
                const float rs = rsqrtf(pre[ai * 4 + m] * (1.0f / 1024.0f) + EPS), rs2 = rs * rs, rsl = -1.4426950408889634f * rs;
                float hv[8];
#pragma unroll
                for (int n = 0; n < 2; ++n)
#pragma unroll
                    for (int j = 0; j < 4; ++j) { const float a0 = acc[ai][0][m][n][j];
                        hv[4 * n + j] = (a0 * acc[ai][1][m][n][j]) * rs2 * __builtin_amdgcn_rcpf(1.f + __builtin_amdgcn_exp2f(a0 * rsl)); }
                u32x4 w; w.x = pk2(hv[0], hv[1]); w.y = pk2(hv[2], hv[3]); w.z = pk2(hv[4], hv[5]); w.w = pk2(hv[6], hv[7]);
                PG8_STH((u32x4*)(H + (size_t)r * FF + col0), w);
            }
    }
};
struct EpiResidual {
    static constexpr bool PERM = true;
    const bf16_t* base; bf16_t* XB; float* ss; int dry; LAS unsigned char* lds;
    DI void prefetch(float (&pre)[8], const Unit&, int, int) const {
#pragma unroll
        for (int k = 0; k < 8; ++k) pre[k] = 0.f;
    }
    DI void operator()(const f32x4 (&acc)[2][2][4][2], const Unit& u, int wr, int wc, int fr, int fq, const float (&)[8]) const {
        const int col0 = u.pn * BM + wc * 32 + 8 * fq;
        float qv[8];
#pragma unroll
        for (int ai = 0; ai < 2; ++ai) {
            u32x4 bv[4][2];
#pragma unroll
            for (int m = 0; m < 4; ++m) { const bf16_t* bp = base + (size_t)(u.pm * BM + ai * HALF + wr * 64 + m * 16 + fr) * D + col0;
#pragma unroll
                for (int bj = 0; bj < 2; ++bj) bv[m][bj] = *(const u32x4*)(bp + bj * HALF); }
#pragma unroll
            for (int m = 0; m < 4; ++m) {
                const int r = u.pm * BM + ai * HALF + wr * 64 + m * 16 + fr;
                float q = 0.f;
#pragma unroll
                for (int bj = 0; bj < 2; ++bj) {
                    const u32x4 b4 = bv[m][bj];
                    const f32x4 o0 = (f32x4){bflo(b4.x), bfhi(b4.x), bflo(b4.y), bfhi(b4.y)} + acc[ai][bj][m][0];
                    const f32x4 o1 = (f32x4){bflo(b4.z), bfhi(b4.z), bflo(b4.w), bfhi(b4.w)} + acc[ai][bj][m][1];
                    u32x4 w; w.x = pk2(o0[0], o0[1]); w.y = pk2(o0[2], o0[3]); w.z = pk2(o1[0], o1[1]); w.w = pk2(o1[2], o1[3]);
                    if (dry != 1) PG8_ST((u32x4*)(XB + (size_t)r * D + col0 + bj * HALF), w);
                    q += ((o0[0] * o0[0] + o0[1] * o0[1]) + (o0[2] * o0[2] + o0[3] * o0[3])) + ((o1[0] * o1[0] + o1[1] * o1[1]) + (o1[2] * o1[2] + o1[3] * o1[3]));
                }
                qv[ai * 4 + m] = q;
            }
            asm volatile("" ::: "memory");
        }
#pragma unroll
        for (int k = 0; k < 8; ++k) qv[k] += __shfl_xor(qv[k], 16);
#pragma unroll
        for (int k = 0; k < 8; ++k) qv[k] += __shfl_xor(qv[k], 32);
        LAS float* part = (LAS float*)(lds + STAGE_BYTES);
        if (fq == 0) {
#pragma unroll
            for (int k = 0; k < 8; ++k) part[wc * 256 + (k >> 2) * HALF + wr * 64 + (k & 3) * 16 + fr] = qv[k];
        }
        asm volatile("s_waitcnt lgkmcnt(0)" ::: "memory");
        __builtin_amdgcn_s_barrier();
        if (wr == 0 && dry != 1) { const int row = wc * 64 + fq * 16 + fr;
            atomicAdd(ss + u.pm * BM + row, (part[row] + part[256 + row]) + (part[512 + row] + part[768 + row])); }
    }
};

struct EpiResidualFinal {
    static constexpr bool PERM = true;
    const bf16_t* base; float* Y; const float* w; unsigned long long* slots; LAS unsigned char* lds;
    DI void prefetch(float (&pre)[8], const Unit&, int, int) const {
#pragma unroll
        for (int k = 0; k < 8; ++k) pre[k] = 0.f;
    }
    DI void operator()(f32x4 (&acc)[2][2][4][2], const Unit& u, int wr, int wc, int fr, int fq, const float (&)[8]) const {
        const int col0 = u.pn * BM + wc * 32 + 8 * fq;
        float qv[8];
#pragma unroll
        for (int ai = 0; ai < 2; ++ai) {
            u32x4 bv[4][2];
#pragma unroll
            for (int m = 0; m < 4; ++m) { const bf16_t* bp = base + (size_t)(u.pm * BM + ai * HALF + wr * 64 + m * 16 + fr) * D + col0;
#pragma unroll
                for (int bj = 0; bj < 2; ++bj) bv[m][bj] = *(const u32x4*)(bp + bj * HALF); }
#pragma unroll
            for (int m = 0; m < 4; ++m) {
                float q = 0.f;
#pragma unroll
                for (int bj = 0; bj < 2; ++bj) {
                    const u32x4 b4 = bv[m][bj];
                    const f32x4 o0 = (f32x4){bflo(b4.x), bfhi(b4.x), bflo(b4.y), bfhi(b4.y)} + acc[ai][bj][m][0];
                    const f32x4 o1 = (f32x4){bflo(b4.z), bfhi(b4.z), bflo(b4.w), bfhi(b4.w)} + acc[ai][bj][m][1];
                    acc[ai][bj][m][0] = o0; acc[ai][bj][m][1] = o1;
                    q += ((o0[0] * o0[0] + o0[1] * o0[1]) + (o0[2] * o0[2] + o0[3] * o0[3])) + ((o1[0] * o1[0] + o1[1] * o1[1]) + (o1[2] * o1[2] + o1[3] * o1[3]));
                }
                qv[ai * 4 + m] = q;
            }
            asm volatile("" ::: "memory");
        }
#pragma unroll
        for (int k = 0; k < 8; ++k) qv[k] += __shfl_xor(qv[k], 16);
#pragma unroll
        for (int k = 0; k < 8; ++k) qv[k] += __shfl_xor(qv[k], 32);
        LAS float* part = (LAS float*)(lds + STAGE_BYTES);
        LAS float* rsrow = part + 1024;
        if (fq == 0) {
#pragma unroll
            for (int k = 0; k < 8; ++k) part[wc * 256 + (k >> 2) * HALF + wr * 64 + (k & 3) * 16 + fr] = qv[k];
        }
        asm volatile("s_waitcnt lgkmcnt(0)" ::: "memory");
        __builtin_amdgcn_s_barrier();
        if (wr == 0) {
            const int row = wc * 64 + fq * 16 + fr;
            const float s = (part[row] + part[256 + row]) + (part[512 + row] + part[768 + row]);
            unsigned long long* sl = slots + (size_t)u.pm * 1024 + row;
            __hip_atomic_store(sl + u.pn * 256, ((unsigned long long)__float_as_uint(s) << 32) | 1ull, __ATOMIC_RELAXED, __HIP_MEMORY_SCOPE_AGENT);
            float tot = s;
#pragma unroll
            for (int j = 1; j < 4; ++j) {
                unsigned long long* p = sl + ((u.pn + j) & 3) * 256;
                unsigned long long v = __hip_atomic_load(p, __ATOMIC_RELAXED, __HIP_MEMORY_SCOPE_AGENT);
                for (unsigned sp = 0; (unsigned)v != 1u && sp < (1u << 22); ++sp) { __builtin_amdgcn_s_sleep(1); v = __hip_atomic_load(p, __ATOMIC_RELAXED, __HIP_MEMORY_SCOPE_AGENT); }
                tot += __uint_as_float((unsigned)(v >> 32));
            }
            rsrow[row] = rsqrtf(tot * (1.0f / 1024.0f) + EPS);
        }
        asm volatile("s_waitcnt lgkmcnt(0)" ::: "memory");
        __builtin_amdgcn_s_barrier();
        f32x4 wv[2][2];
#pragma unroll
        for (int bj = 0; bj < 2; ++bj) { wv[bj][0] = *(const f32x4*)(w + col0 + bj * HALF); wv[bj][1] = *(const f32x4*)(w + col0 + bj * HALF + 4); }
#pragma unroll
        for (int ai = 0; ai < 2; ++ai)
#pragma unroll
            for (int m = 0; m < 4; ++m) {
                const int rl = ai * HALF + wr * 64 + m * 16 + fr;
                const float rs = rsrow[rl];
                float* yp = Y + (size_t)(u.pm * BM + rl) * D + col0;
#pragma unroll
                for (int bj = 0; bj < 2; ++bj) {
                    PG8_ST((f32x4*)(yp + bj * HALF), acc[ai][bj][m][0] * rs * wv[bj][0]);
                    PG8_ST((f32x4*)(yp + bj * HALF + 4), acc[ai][bj][m][1] * rs * wv[bj][1]);
                }
            }
    }
};

enum { TAIL_SCALE = 0, TAIL_SWIGLU = 1, TAIL_RES = 2 };
struct TailArgs { const bf16_t* A; const bf16_t* Bt; int K; int N;
                  bf16_t* O; int ldo; const float* ss_in;
                  const bf16_t* base; bf16_t* XB; float* ss_out;
                  int cp_phase; const f32x4* cp_src[2]; f32x4* cp_dst[2]; };
template <int MODE>
DI void gemm_tail(const TailArgs& t, int G) {
    int tid = threadIdx.x; asm volatile("" : "+v"(tid));
    const int lane = tid & 63, wave = __builtin_amdgcn_readfirstlane(tid >> 6), fr = lane & 15, fq = lane >> 4;
    const int NT = t.N / 16, nitems = 8 * NT, K = t.K;
    for (int it = wave * G + (int)blockIdx.x; it < nitems; it += 8 * G) {
        const int mt = it & 7, nt = it >> 3;
        const bf16_t* ap = t.A + (size_t)(MP + 16 * mt + fr) * K + 8 * fq;
        int brow;
        if (MODE == TAIL_SWIGLU) brow = (nt >> 3) * 256 + (nt & 7) * 16 + fr; else brow = 16 * nt + fr;
        const bf16_t* bp = t.Bt + (size_t)brow * K + 8 * fq;
        f32x4 acc0 = (f32x4){0.f, 0.f, 0.f, 0.f}, acc1 = acc0;
        constexpr int KS = (MODE == TAIL_SWIGLU) ? 4 : 8, KB = 32 * KS;
        bf16x8 av[2][KS], bv[2][KS], cv[2][KS];
#define TL_LOAD(buf, kk) do { _Pragma("unroll") for (int ks = 0; ks < KS; ++ks) { av[buf][ks] = *(const bf16x8*)(ap + (kk) + 32 * ks); bv[buf][ks] = *(const bf16x8*)(bp + (kk) + 32 * ks); \
            if (MODE == TAIL_SWIGLU) cv[buf][ks] = *(const bf16x8*)(bp + (size_t)128 * K + (kk) + 32 * ks); } } while (0)
#define TL_MMA(buf) do { _Pragma("unroll") for (int ks = 0; ks < KS; ++ks) { acc0 = __builtin_amdgcn_mfma_f32_16x16x32_bf16(bv[buf][ks], av[buf][ks], acc0, 0, 0, 0); \
            if (MODE == TAIL_SWIGLU) acc1 = __builtin_amdgcn_mfma_f32_16x16x32_bf16(cv[buf][ks], av[buf][ks], acc1, 0, 0, 0); } } while (0)
#define TL_SB __builtin_amdgcn_sched_barrier(0)
        TL_LOAD(0, 0);
        int k0 = 0;
        for (; k0 + 2 * KB <= K; k0 += 2 * KB) { TL_SB; TL_LOAD(1, k0 + KB); TL_SB; TL_MMA(0); TL_SB; if (k0 + 2 * KB < K) TL_LOAD(0, k0 + 2 * KB); TL_SB; TL_MMA(1); }
        TL_SB;
        if (k0 < K) TL_MMA(0);
#undef TL_SB
#undef TL_LOAD
#undef TL_MMA
        const int m = 16 * mt + fr, c = 16 * nt + 4 * fq;
        if (MODE == TAIL_SCALE) {
            const float rs = rsqrtf(t.ss_in[MP + m] * (1.0f / 1024.0f) + EPS);
            *(u32x2*)(t.O + (size_t)(MP + m) * t.ldo + c) = (u32x2){pk2(acc0[0] * rs, acc0[1] * rs), pk2(acc0[2] * rs, acc0[3] * rs)};
        } else if (MODE == TAIL_SWIGLU) {
            const float rs = rsqrtf(t.ss_in[MP + m] * (1.0f / 1024.0f) + EPS);
            float hv[4];
#pragma unroll
            for (int j = 0; j < 4; ++j) { const float g = acc0[j] * rs, up = acc1[j] * rs; hv[j] = g * __builtin_amdgcn_rcpf(1.f + __expf(-g)) * up; }
            *(u32x2*)(t.O + (size_t)(MP + m) * t.ldo + c) = (u32x2){pk2(hv[0], hv[1]), pk2(hv[2], hv[3])};
        } else {
            const u32x2 b2 = *(const u32x2*)(t.base + (size_t)(MP + m) * D + c);
            const f32x4 o = (f32x4){bflo(b2.x), bfhi(b2.x), bflo(b2.y), bfhi(b2.y)} + acc0;
            *(u32x2*)(t.XB + (size_t)(MP + m) * D + c) = (u32x2){pk2(o[0], o[1]), pk2(o[2], o[3])};
            float q = (o[0] * o[0] + o[1] * o[1]) + (o[2] * o[2] + o[3] * o[3]);
            q += __shfl_xor(q, 16); q += __shfl_xor(q, 32);
            if (fq == 0) atomicAdd(t.ss_out + MP + m, q);
        }
    }
    if (MODE == TAIL_RES && t.cp_phase >= 0) {
        const int widx = wave * G + (int)blockIdx.x, nidle = 8 * G - nitems;
        if (widx >= nitems && nidle > 0) {
            const int total = 2 * 128 * 8128, nsl = 4 * nidle, sl = t.cp_phase * nidle + (widx - nitems);
            const int per = (total + nsl - 1) / nsl, p0 = sl * per, p1 = (p0 + per < total) ? p0 + per : total;
            for (int pc = p0 + lane; pc < p1; pc += 64) { const int tsel = pc >= 128 * 8128, off = pc - tsel * 128 * 8128, smp = off / 8128, w = off - smp * 8128;
                (tsel ? t.cp_dst[1] : t.cp_dst[0])[smp * 8192 + w] = (tsel ? t.cp_src[1] : t.cp_src[0])[smp * 8192 + 64 + w]; }
        }
    }
}

DI void gemm_tail_res(const TailArgs& t, int G, LAS unsigned char* lds) {
    int tid = threadIdx.x; asm volatile("" : "+v"(tid));
    const int lane = tid & 63, wave = __builtin_amdgcn_readfirstlane(tid >> 6), fr = lane & 15, fq = lane >> 4;
    const int K = t.K, ntiles = 8 * (t.N / 16), nch = K >> 8, half = wave >> 2, split = wave & 3;
    LAS f32x4* red = (LAS f32x4*)lds;
    for (int pair = (int)blockIdx.x; 2 * pair < ntiles; pair += G) {
        const int tile = 2 * pair + half, mt = tile & 7, nt = tile >> 3;
        const bf16_t* ap = t.A + (size_t)(MP + 16 * mt + fr) * K + 8 * fq;
        const bf16_t* bp = t.Bt + (size_t)(16 * nt + fr) * K + 8 * fq;
        f32x4 acc0 = (f32x4){0.f, 0.f, 0.f, 0.f};
        bf16x8 av[2][8], bv[2][8];
#define TR_LOAD(buf, kk) do { _Pragma("unroll") for (int ks = 0; ks < 8; ++ks) { av[buf][ks] = *(const bf16x8*)(ap + (kk) + 32 * ks); bv[buf][ks] = *(const bf16x8*)(bp + (kk) + 32 * ks); } } while (0)
#define TR_MMA(buf) do { _Pragma("unroll") for (int ks = 0; ks < 8; ++ks) acc0 = __builtin_amdgcn_mfma_f32_16x16x32_bf16(bv[buf][ks], av[buf][ks], acc0, 0, 0, 0); } while (0)
        int c = split;
        if (c < nch) TR_LOAD(0, c * 256);
        while (c < nch) {
            __builtin_amdgcn_sched_barrier(0);
            if (c + 4 < nch) TR_LOAD(1, (c + 4) * 256);
            __builtin_amdgcn_sched_barrier(0);
            TR_MMA(0);
            c += 4; if (c >= nch) break;
            __builtin_amdgcn_sched_barrier(0);
            if (c + 4 < nch) TR_LOAD(0, (c + 4) * 256);
            __builtin_amdgcn_sched_barrier(0);
            TR_MMA(1);
            c += 4;
        }
#undef TR_LOAD
#undef TR_MMA
        if (split > 0) red[(half * 3 + split - 1) * 64 + lane] = acc0;
        __syncthreads();
        if (split == 0) {
            acc0 += (red[(half * 3 + 0) * 64 + lane] + red[(half * 3 + 1) * 64 + lane]) + red[(half * 3 + 2) * 64 + lane];
            const int m = 16 * mt + fr, cc = 16 * nt + 4 * fq;
            const u32x2 b2 = *(const u32x2*)(t.base + (size_t)(MP + m) * D + cc);
            const f32x4 o = (f32x4){bflo(b2.x), bfhi(b2.x), bflo(b2.y), bfhi(b2.y)} + acc0;
            *(u32x2*)(t.XB + (size_t)(MP + m) * D + cc) = (u32x2){pk2(o[0], o[1]), pk2(o[2], o[3])};
            float q = (o[0] * o[0] + o[1] * o[1]) + (o[2] * o[2] + o[3] * o[3]);
            q += __shfl_xor(q, 16); q += __shfl_xor(q, 32);
            if (fq == 0) atomicAdd(t.ss_out + MP + m, q);
        }
        if (2 * (pair + G) < ntiles) __syncthreads();
    }
    if (t.cp_phase >= 0 && split > 0) {
        const int nw = 6 * G, widx = (int)blockIdx.x * 6 + half * 3 + (split - 1);
        const int total = 2 * 128 * 8128, nsl = 4 * nw, sl = t.cp_phase * nw + widx;
        const int per = (total + nsl - 1) / nsl, p0 = sl * per, p1 = (p0 + per < total) ? p0 + per : total;
        for (int pb = p0 + lane; pb < p1; pb += 6 * 64) {
            f32x4 tmp[6];
#pragma unroll
            for (int j = 0; j < 6; ++j) { const int pc = pb + 64 * j; if (pc < p1) { const int tsel = pc >= 128 * 8128, off = pc - tsel * 128 * 8128, smp = off / 8128, w = off - smp * 8128;
                tmp[j] = (tsel ? t.cp_src[1] : t.cp_src[0])[smp * 8192 + 64 + w]; } }
            __builtin_amdgcn_sched_barrier(0);
#pragma unroll
            for (int j = 0; j < 6; ++j) { const int pc = pb + 64 * j; if (pc < p1) { const int tsel = pc >= 128 * 8128, off = pc - tsel * 128 * 8128, smp = off / 8128, w = off - smp * 8128;
                (tsel ? t.cp_dst[1] : t.cp_dst[0])[smp * 8192 + w] = tmp[j]; } }
        }
    }
    __syncthreads();
}

template <class Epi>
DI void gemm_phase(LAS unsigned char* lds, const Gemm g, const StaticOrder& S, const Epi& E) {
    const int tid = threadIdx.x, wid = __builtin_amdgcn_readfirstlane(tid >> 6), lane = tid & 63, wr = wid >> 2, wc = wid & 3, fr = lane & 15, fq = lane >> 4;
    const int K = g.K, nt = K / BK;
    unsigned voffA[2], voffB[2];
#pragma unroll
    for (int i = 0; i < 2; ++i) { int R, C; stage_rc(tid * 16 + i * 8192, R, C); const int Rb = Epi::PERM ? ((R & ~31) + perm32(R & 31)) : R;
        voffA[i] = (unsigned)(R * K + C) * 2u; voffB[i] = (unsigned)(Rb * K + C) * 2u; }
    const size_t kstep = (size_t)(BK * 2);
    const size_t hstep = (size_t)HALF * K * 2;
    const size_t tstep = 2 * hstep;
    const unsigned ldsw = (unsigned)wid * 1024u;
    const int aoff = lds_byte(wr * 64 + fr, fq * 8), boff = lds_byte(wc * 32 + fr, fq * 8);
#define PG8_SA(b, h) (((b) * 2 + (h)) * HTB)
#define PG8_SB(b, h) ((4 + (b) * 2 + (h)) * HTB)
#define PG8_STAGE(bufoff, gbase, voff) do { _Pragma("unroll") for (int _i = 0; _i < 2; ++_i) \
        __builtin_amdgcn_global_load_lds((const unsigned*)((const char*)(gbase) + (voff)[_i]), (LAS unsigned*)(lds + (bufoff) + ldsw + _i * 8192), 16, 0, 0); } while (0)
#define PG8_LDA(dst, b, h) do { _Pragma("unroll") for (int m = 0; m < 4; ++m) _Pragma("unroll") for (int k = 0; k < 2; ++k) dst[m][k] = *(const LAS bf16x8*)(lds + PG8_SA(b, h) + aoff + m * 2048 + k * 1024); } while (0)
#define PG8_LDB(dst, b, h) do { _Pragma("unroll") for (int n = 0; n < 2; ++n) _Pragma("unroll") for (int k = 0; k < 2; ++k) dst[n][k] = *(const LAS bf16x8*)(lds + PG8_SB(b, h) + boff + n * 2048 + k * 1024); } while (0)
#define PG8_MMA(ai, bj, At, Bt) do { __builtin_amdgcn_s_setprio(1); _Pragma("unroll") for (int m = 0; m < 4; ++m) _Pragma("unroll") for (int n = 0; n < 2; ++n) _Pragma("unroll") for (int k = 0; k < 2; ++k) \
        acc[ai][bj][m][n] = __builtin_amdgcn_mfma_f32_16x16x32_bf16(Bt[n][k], At[m][k], acc[ai][bj][m][n], 0, 0, 0); __builtin_amdgcn_s_setprio(0); } while (0)
#define PG8_WAIT_V(n) asm volatile("s_waitcnt vmcnt(" #n ")" ::: "memory")
#define PG8_WAIT_L(n) asm volatile("s_waitcnt lgkmcnt(" #n ")" ::: "memory")
#define PG8_BAR __builtin_amdgcn_s_barrier()
#define PG8_SCHED __builtin_amdgcn_sched_barrier(0)
    Unit cur, nxt; int ui = 0;
    if (!S.next(0, cur)) return;
    f32x4 acc[2][2][4][2];
#pragma unroll
    for (int a = 0; a < 2; ++a)
#pragma unroll
        for (int b = 0; b < 2; ++b)
#pragma unroll
            for (int m = 0; m < 4; ++m)
#pragma unroll
                for (int n = 0; n < 2; ++n) acc[a][b][m][n] = (f32x4){0.f, 0.f, 0.f, 0.f};
    bf16x8 At[4][2], B0[2][2], B1[2][2];
    float pre[8];
    const char* cA = (const char*)g.A + (size_t)cur.pm * tstep; const char* cB = (const char*)g.Bt + (size_t)cur.pn * tstep;
    if (PG8_SP2) {
        PG8_STAGE(PG8_SB(0, 0), cB, voffB); PG8_STAGE(PG8_SB(0, 1), cB + hstep, voffB); PG8_STAGE(PG8_SA(0, 0), cA, voffA); PG8_STAGE(PG8_SA(0, 1), cA + hstep, voffA);
        if (wr == 1) PG8_BAR;
        PG8_WAIT_V(2); PG8_BAR;
        PG8_STAGE(PG8_SB(1, 0), cB + kstep, voffB); PG8_STAGE(PG8_SA(1, 0), cA + kstep, voffA); PG8_STAGE(PG8_SB(1, 1), cB + hstep + kstep, voffB);
        PG8_WAIT_V(6); PG8_BAR;
    } else {
    PG8_STAGE(PG8_SB(0, 0), cB, voffB); PG8_STAGE(PG8_SA(0, 0), cA, voffA); PG8_STAGE(PG8_SB(0, 1), cB + hstep, voffB); PG8_STAGE(PG8_SA(0, 1), cA + hstep, voffA);
    if (wr == 1) PG8_BAR;
    PG8_WAIT_V(4); PG8_BAR;
    PG8_STAGE(PG8_SB(1, 0), cB + kstep, voffB); PG8_STAGE(PG8_SA(1, 0), cA + kstep, voffA); PG8_STAGE(PG8_SB(1, 1), cB + hstep + kstep, voffB);
    PG8_WAIT_V(6); PG8_BAR;
    }
    for (;;) {
        const bool has_next = S.next(ui + 1, nxt);
        const char* nA = has_next ? (const char*)g.A + (size_t)nxt.pm * tstep : cA; const char* nB = has_next ? (const char*)g.Bt + (size_t)nxt.pn * tstep : cB;
        for (int t = 0; t < nt; t += 2) {
            const bool last = (t == nt - 2);
            const char* a1 = cA + (size_t)(t + 1) * kstep;
            const char* a2 = last ? nA : cA + (size_t)(t + 2) * kstep; const char* b2 = last ? nB : cB + (size_t)(t + 2) * kstep;
            const char* a3 = a2 + kstep; const char* b3 = b2 + kstep;
            if (last) E.prefetch(pre, cur, wr, fr);
            if (PG8_SP2) {
            PG8_LDB(B0, 0, 0); PG8_LDB(B1, 0, 1); PG8_SCHED; PG8_LDA(At, 0, 0); PG8_STAGE(PG8_SA(1, 1), a1 + hstep, voffA);
            PG8_WAIT_V(8); PG8_WAIT_L(0); PG8_BAR; PG8_MMA(0, 0, At, B0); PG8_MMA(0, 1, At, B1); PG8_BAR; PG8_SCHED;
            PG8_LDA(At, 0, 1); PG8_STAGE(PG8_SB(0, 0), b2, voffB); PG8_STAGE(PG8_SB(0, 1), b2 + hstep, voffB); PG8_STAGE(PG8_SA(0, 0), a2, voffA);
            PG8_WAIT_V(8); PG8_WAIT_L(0); PG8_BAR; PG8_MMA(1, 0, At, B0); PG8_MMA(1, 1, At, B1); PG8_BAR; PG8_SCHED;
            PG8_LDB(B0, 1, 0); PG8_LDB(B1, 1, 1); PG8_SCHED; PG8_LDA(At, 1, 0); PG8_STAGE(PG8_SA(0, 1), a2 + hstep, voffA);
            PG8_WAIT_V(8); PG8_WAIT_L(0); PG8_BAR; PG8_MMA(0, 0, At, B0); PG8_MMA(0, 1, At, B1); PG8_BAR; PG8_SCHED;
            PG8_LDA(At, 1, 1); PG8_STAGE(PG8_SB(1, 0), b3, voffB); PG8_STAGE(PG8_SB(1, 1), b3 + hstep, voffB); PG8_STAGE(PG8_SA(1, 0), a3, voffA);
            PG8_WAIT_V(8); PG8_WAIT_L(0); PG8_BAR; PG8_MMA(1, 0, At, B0); PG8_MMA(1, 1, At, B1); PG8_BAR; PG8_SCHED;
            } else {
            PG8_LDB(B0, 0, 0); PG8_SCHED; PG8_LDA(At, 0, 0); PG8_STAGE(PG8_SA(1, 1), a1 + hstep, voffA);
            PG8_WAIT_L(8); PG8_BAR; PG8_WAIT_L(0); PG8_MMA(0, 0, At, B0); PG8_BAR; PG8_SCHED;
            PG8_LDB(B1, 0, 1); PG8_STAGE(PG8_SB(0, 0), b2, voffB);
            PG8_BAR; PG8_WAIT_L(0); PG8_MMA(0, 1, At, B1); PG8_BAR;
            PG8_LDA(At, 0, 1); PG8_STAGE(PG8_SA(0, 0), a2, voffA);
            PG8_BAR; PG8_WAIT_L(0); PG8_MMA(1, 0, At, B0); PG8_BAR; PG8_SCHED;
            PG8_STAGE(PG8_SB(0, 1), b2 + hstep, voffB);
            PG8_WAIT_V(6); PG8_BAR; PG8_MMA(1, 1, At, B1); PG8_BAR;
            PG8_LDB(B0, 1, 0); PG8_SCHED; PG8_LDA(At, 1, 0); PG8_STAGE(PG8_SA(0, 1), a2 + hstep, voffA);
            PG8_WAIT_L(8); PG8_BAR; PG8_WAIT_L(0); PG8_MMA(0, 0, At, B0); PG8_BAR; PG8_SCHED;
            PG8_LDB(B1, 1, 1); PG8_STAGE(PG8_SB(1, 0), b3, voffB);
            PG8_BAR; PG8_WAIT_L(0); PG8_MMA(0, 1, At, B1); PG8_BAR;
            PG8_LDA(At, 1, 1); PG8_STAGE(PG8_SA(1, 0), a3, voffA);
            PG8_BAR; PG8_WAIT_L(0); PG8_MMA(1, 0, At, B0); PG8_BAR; PG8_SCHED;
            PG8_STAGE(PG8_SB(1, 1), b3 + hstep, voffB);
            PG8_WAIT_V(6); PG8_BAR; PG8_MMA(1, 1, At, B1); PG8_BAR;
            }
        }
        if (PG8_ALIGN_EPI) { if (wr == 0) PG8_BAR; }
        E(acc, cur, wr, wc, fr, fq, pre);
        if (!has_next) break;
#pragma unroll
        for (int a = 0; a < 2; ++a)
#pragma unroll
            for (int b = 0; b < 2; ++b)
#pragma unroll
                for (int m = 0; m < 4; ++m)
#pragma unroll
                    for (int n = 0; n < 2; ++n) acc[a][b][m][n] = (f32x4){0.f, 0.f, 0.f, 0.f};
        cur = nxt; cA = nA; cB = nB; ++ui;
        if (PG8_ALIGN_EPI) { if (wr == 1) PG8_BAR; }
    }
    PG8_WAIT_V(0);
    if (!PG8_ALIGN_EPI) { if (wr == 0) PG8_BAR; }
    PG8_BAR;
#undef PG8_SA
#undef PG8_SB
#undef PG8_STAGE
#undef PG8_LDA
#undef PG8_LDB
#undef PG8_MMA
#undef PG8_WAIT_V
#undef PG8_WAIT_L
#undef PG8_BAR
#undef PG8_SCHED
}
}
struct TrJob { const float* W; int ldw; int K; const float* sc; bf16_t* WT; int nblk32; int kind; };
DI int tr_src_col(int kind, int d0) {
    if (kind == 1) return d0 < 2048 ? d0 : d0 + 8;
    if (kind == 2) { const int pn = d0 >> 8, c0 = d0 & 255; return c0 < 128 ? pn * 128 + c0 : FF + pn * 128 + (c0 - 128); }
    return d0;
}
struct TrItem { const float* src; const float* sc; bf16_t* dst; int ldw; int K; };
DI void p0_tr_decode(const TrJob (&J)[8], const int (&cnt)[8], int it, TrItem& T) {
    int r = it; T.src = nullptr;
#pragma unroll
    for (int j = 0; j < 8; ++j) {
        if (r >= 0 && r < cnt[j]) { const int nb64 = J[j].nblk32 >> 1, kb = r / nb64, nb = r % nb64, k0 = 64 * kb, d0 = 64 * nb, n0 = tr_src_col(J[j].kind, d0);
            T.src = J[j].W + (size_t)k0 * J[j].ldw + n0; T.sc = J[j].sc ? J[j].sc + k0 : nullptr; T.dst = J[j].WT + (size_t)d0 * J[j].K + k0; T.ldw = J[j].ldw; T.K = J[j].K; r = -1; }
        else if (r >= 0) r -= cnt[j];
    }
}
#define P0_TR_LOAD(V, T) do { _Pragma("unroll") for (int i = 0; i < 16; ++i) V[i] = *(const f32x4*)((T).src + (size_t)(4 * i + (lane >> 4)) * (T).ldw + 4 * (lane & 15)); } while (0)
DI void p0_tr_finish(const f32x4 (&V)[16], const TrItem& T, LAS float* scr, int lane) {
#pragma unroll
    for (int i = 0; i < 16; ++i) { const int kk = 4 * i + (lane >> 4); f32x4 v = V[i]; if (T.sc) v = v * T.sc[kk];
        LAS float* d = scr + kk * 65 + 4 * (lane & 15); d[0] = v[0]; d[1] = v[1]; d[2] = v[2]; d[3] = v[3]; }
    asm volatile("s_waitcnt lgkmcnt(0)" ::: "memory");
    const int c = lane & 7;
#pragma unroll
    for (int j = 0; j < 8; ++j) { const int n = (lane >> 3) + 8 * j; const LAS float* s = scr + (8 * c) * 65 + n;
        u32x4 o; o.x = pk2(s[0 * 65], s[1 * 65]); o.y = pk2(s[2 * 65], s[3 * 65]); o.z = pk2(s[4 * 65], s[5 * 65]); o.w = pk2(s[6 * 65], s[7 * 65]);
        *(u32x4*)(T.dst + (size_t)n * T.K + 8 * c) = o; }
    asm volatile("s_waitcnt lgkmcnt(0)" ::: "memory");
}
DI void p0_prologue(const Params& P, LAS unsigned char* lds, int vcu, int G) {
    int tid = threadIdx.x; asm volatile("" : "+v"(tid)); const int lane = tid & 63, wave = __builtin_amdgcn_readfirstlane(tid >> 6);
    LAS float* scr = (LAS float*)(lds + wave * 16896);
    const int gw = vcu * 8 + wave, NGW = G * 8;
    bf16_t* Wb = (bf16_t*)(P.ws + WS_W);
    {
        int cnt[8]; TrJob J[8];
        J[0] = TrJob{P.in[I_WIN], 3080, D, P.in[I_NMIX], Wb + W_IN, NIN / 32, 1};
        J[1] = TrJob{P.in[I_WOUTAB], D, D, nullptr, Wb + W_OUTAB, D / 32, 0};
        J[2] = TrJob{P.in[I_WGU], NGU, D, P.in[I_NFFN], Wb + W_GU0, NGU / 32, 2};
        J[3] = TrJob{P.in[I_WGU] + (size_t)D * NGU, NGU, D, P.in[I_NFFN] + D, Wb + W_GU1, NGU / 32, 2};
        J[4] = TrJob{P.in[I_WDN], D, FF, nullptr, Wb + W_DN0, D / 32, 0};
        J[5] = TrJob{P.in[I_WDN] + (size_t)FF * D, D, FF, nullptr, Wb + W_DN1, D / 32, 0};
        J[6] = TrJob{P.in[I_WQKV], NQKV, D, P.in[I_NMIX] + D, Wb + W_QKV, NQKV / 32, 0};
        J[7] = TrJob{P.in[I_WOUTC], D, D, nullptr, Wb + W_OUTC, D / 32, 0};
        int total = 0;
#pragma unroll
        for (int j = 0; j < 8; ++j) { cnt[j] = (J[j].nblk32 >> 1) * (J[j].K / 64); total += cnt[j]; }
        f32x4 VA[16], VB[16]; TrItem TA, TB;
        int it = gw;
        if (it < total) { p0_tr_decode(J, cnt, it, TA); P0_TR_LOAD(VA, TA); }
        while (it < total) {
            const int itb = it + NGW;
            if (itb < total) { p0_tr_decode(J, cnt, itb, TB); P0_TR_LOAD(VB, TB); }
            p0_tr_finish(VA, TA, scr, lane);
            const int ita = itb + NGW;
            if (ita < total) { p0_tr_decode(J, cnt, ita, TA); P0_TR_LOAD(VA, TA); }
            if (itb < total) p0_tr_finish(VB, TB, scr, lane);
            it = ita;
        }
    }
    {
        bf16_t* XB = (bf16_t*)P.out; float* ss0 = (float*)(P.ws + WS_SS); float* BA = (float*)(P.ws + WS_BA);
        const float* nm = P.in[I_NMIX]; const float* win = P.in[I_WIN];
        float wq[4][4][8];
#pragma unroll
        for (int j = 0; j < 4; ++j)
#pragma unroll
            for (int e = 0; e < 4; ++e) { const int k = 256 * j + 4 * lane + e; const float gk = nm[k];
                const f32x4 a = *(const f32x4*)(win + (size_t)k * 3080 + 2048), b = *(const f32x4*)(win + (size_t)k * 3080 + 2052);
                wq[j][e][0] = a[0] * gk; wq[j][e][1] = a[1] * gk; wq[j][e][2] = a[2] * gk; wq[j][e][3] = a[3] * gk;
                wq[j][e][4] = b[0] * gk; wq[j][e][5] = b[1] * gk; wq[j][e][6] = b[2] * gk; wq[j][e][7] = b[3] * gk; }
        f32x4 vn[4];
#define P0_ROW_LOAD(m_) do { const float* xr_ = ((m_) < MP) ? P.in[I_XP] + (size_t)(m_) * D : P.in[I_XS] + (size_t)((m_) - MP) * D; \
            _Pragma("unroll") for (int j = 0; j < 4; ++j) vn[j] = *((const f32x4*)xr_ + 64 * j + lane); } while (0)
        if (gw < MREAL) P0_ROW_LOAD(gw);
        for (int m = gw; m < MREAL; m += NGW) {
            f32x4 v[4]; float s = 0.f; float dacc[8];
#pragma unroll
            for (int j = 0; j < 4; ++j) v[j] = vn[j];
            if (m + NGW < MREAL) P0_ROW_LOAD(m + NGW);
#pragma unroll
            for (int c = 0; c < 8; ++c) dacc[c] = 0.f;
#pragma unroll
            for (int j = 0; j < 4; ++j) { s += (v[j][0] * v[j][0] + v[j][1] * v[j][1]) + (v[j][2] * v[j][2] + v[j][3] * v[j][3]);
#pragma unroll
                for (int e = 0; e < 4; ++e)
#pragma unroll
                    for (int c = 0; c < 8; ++c) dacc[c] += v[j][e] * wq[j][e][c]; }
            s = wave_sum(s);
#pragma unroll
            for (int c = 0; c < 8; ++c) dacc[c] = wave_sum(dacc[c]);
            const float rs = rsqrtf(s * (1.0f / 1024.0f) + EPS);
            u32x2* o8 = (u32x2*)(XB + (size_t)m * D) + lane;
#pragma unroll
            for (int j = 0; j < 4; ++j) { u32x2 w; w.x = pk2(v[j][0], v[j][1]); w.y = pk2(v[j][2], v[j][3]); o8[64 * j] = w; }
            if (lane == 0) { ss0[m] = s; *(f32x4*)(BA + (size_t)m * 8) = (f32x4){dacc[0] * rs, dacc[1] * rs, dacc[2] * rs, dacc[3] * rs}; *(f32x4*)(BA + (size_t)m * 8 + 4) = (f32x4){dacc[4] * rs, dacc[5] * rs, dacc[6] * rs, dacc[7] * rs}; }
        }
#undef P0_ROW_LOAD
        float* ssz = (float*)(P.ws + WS_SS);
        for (int i = vcu * 512 + tid; i < 4 * MPAD; i += G * 512) ssz[MPAD + i] = 0.f;
        for (int i = vcu * 512 + tid; i < MPAD - MREAL; i += G * 512) ssz[MREAL + i] = 0.f;
    }
}
DI int swapb(int t) { return (t & ~12) | ((t & 4) << 1) | ((t & 8) >> 1); }
DI int img256(int row, int chunk) { return row * 256 + ((chunk ^ (row & 15)) << 4); }
DI int img128(int row, int chunk) { const int L = row >> 1, slot = ((row & 1) << 3) | chunk; return L * 256 + ((slot ^ (L & 15)) << 4); }

constexpr int GP_QF = 0, GP_AM = 0, GP_QKM = 17408, GP_KF = 33792, GP_VF = 67584, GP_QB = 101376, GP_KB = 118784, GP_SM = 136192, GP_AB = 137728, GP_TB = 146944;
constexpr int GDNI_WK = 0, GDNI_QD = 16384, GDNI_KT = 32768, GDNI_QK = 49152;

template <int MODE>
DI void gdn_prep_phase(const Params& P, LAS unsigned char* lds, int bx, int G) {
    int tid0 = threadIdx.x; asm volatile("" : "+v"(tid0)); const int wave = __builtin_amdgcn_readfirstlane(tid0 >> 6);
    int tid = tid0; int lane = tid & 63;
    const bf16_t* proj = (const bf16_t*)(P.ws + WS_BIG);
    LAS float* SSQ = (LAS float*)(lds + GP_SM); LAS float* SSK = SSQ + 64; LAS float* BETA = SSQ + 128; LAS float* GAM = SSQ + 192; LAS float* EG = SSQ + 256;
    if (bx >= NCHUNKS) return;
    int g48 = tid % 48, seg = tid / 48, which = g48 >> 4, cg = g48 & 15;
    u32x4 raw[11]; float bav = 0.f, aav = 0.f;
#define GP_LOAD(ci_) do { const int n_ = (ci_) & 31, h_ = ((ci_) >> 5) & 3, b_ = (ci_) >> 7, R0_ = b_ * TSEQ + n_ * 64; \
        if (tid < 384) { const int col_ = which * 512 + h_ * 128 + 8 * cg; \
            _Pragma("unroll") for (int j = 0; j < 11; ++j) { const int t = seg * 8 - 3 + j; raw[j] = (u32x4){0u, 0u, 0u, 0u}; \
                if (n_ > 0 || t >= 0) raw[j] = *(const u32x4*)(proj + (size_t)(R0_ + t) * NIN + col_); } } \
        else if (wave == 6) { const float* BA_ = (const float*)(P.ws + WS_BA) + (size_t)(R0_ + lane) * 8; bav = BA_[h_]; aav = BA_[4 + h_]; } } while (0)
    GP_LOAD(bx);
  for (int ci = bx; ci < NCHUNKS; ci += G) {
    tid = tid0; asm volatile("" : "+v"(tid));
    lane = tid & 63; g48 = tid % 48; seg = tid / 48; which = g48 >> 4; cg = g48 & 15;
    const int n = ci & 31, h = (ci >> 5) & 3, b = ci >> 7;
    const int R0 = b * TSEQ + n * 64;
    unsigned char* gout = MODE ? P.ws + 494 * MiB + (size_t)(ci & 127) * GDNI_STG : P.ws + WS_GDNI + (size_t)ci * GDNI_STG;
    BAR_LDS();
    if (tid >= 448) { const int t = tid - 448; SSQ[t] = 0.f; SSK[t] = 0.f; }
    const u32x4* zsrc = (const u32x4*)(proj + (size_t)(R0 + (tid >> 3)) * NIN + 1536 + h * 128 + 16 * (tid & 7));
    const u32x4 zr0 = zsrc[0], zr1 = zsrc[1];
    f32x4 cw[4][2];
    if (tid < 384) { const int col = which * 512 + h * 128 + 8 * cg;
#pragma unroll
        for (int j = 0; j < 4; ++j) { cw[j][0] = *(const f32x4*)(P.in[I_CONVG] + j * 1536 + col); cw[j][1] = *(const f32x4*)(P.in[I_CONVG] + j * 1536 + col + 4); } }
    BAR_LDS();
    if (tid < 384 && !(MODE & 2)) {
#pragma unroll
        for (int tt = 0; tt < 8; ++tt) {
            float y[8];
#pragma unroll
            for (int e = 0; e < 8; ++e) y[e] = 0.f;
#pragma unroll
            for (int j = 0; j < 4; ++j) { const u32x4 w = raw[tt + j];
                y[0] += cw[j][0][0] * bflo(w.x); y[1] += cw[j][0][1] * bfhi(w.x); y[2] += cw[j][0][2] * bflo(w.y); y[3] += cw[j][0][3] * bfhi(w.y);
                y[4] += cw[j][1][0] * bflo(w.z); y[5] += cw[j][1][1] * bfhi(w.z); y[6] += cw[j][1][2] * bflo(w.w); y[7] += cw[j][1][3] * bfhi(w.w); }
            float q = 0.f;
#pragma unroll
            for (int e = 0; e < 8; ++e) { y[e] = siluf_(y[e]); q += y[e] * y[e]; }
            const int t = seg * 8 + tt;
            LAS float* dst = (LAS float*)(lds + (which == 0 ? GP_QF : (which == 1 ? GP_KF : GP_VF))) + t * 132 + 8 * cg;
            *(LAS f32x4*)dst = (f32x4){y[0], y[1], y[2], y[3]}; *(LAS f32x4*)(dst + 4) = (f32x4){y[4], y[5], y[6], y[7]};
            if (which == 0) atomicAdd((float*)(SSQ + t), q); else if (which == 1) atomicAdd((float*)(SSK + t), q);
        }
    } else if (wave == 6) {
        const int t = lane;
        const float beta = sigmoidf_(bav);
        const float g = -__expf(P.in[I_ALOG][h]) * softplusf_(aav + P.in[I_DTB][h]);
        float c = g;
#pragma unroll
        for (int o = 1; o < 64; o <<= 1) { const float tv = __shfl_up(c, o); if (lane >= o) c += tv; }
        BETA[t] = beta; GAM[t] = c; EG[t] = __expf(c);
        if (lane == 63 && MODE == 0) ((float*)(P.ws + WS_GT))[ci] = __expf(c);
    }
    if (ci + G < NCHUNKS) GP_LOAD(ci + G);
    BAR_LDS();
    if (!(MODE & 32))
#pragma unroll
    for (int rep = 0; rep < 4; ++rep) {
        const int idx = tid + 512 * (rep & 1), i = idx >> 4, sh = idx & 15, s = sh >> 1, hh = sh & 1, d0 = 16 * s + 4 * hh, d1 = d0 + 8;
        if (rep < 2) {
            LAS float* qf = (LAS float*)(lds + GP_QF) + i * 132;
            const float rn = rsqrtf(SSQ[i] + EPS) * 0.08838834764831845f;
            const f32x4 a = *(LAS f32x4*)(qf + d0) * rn, c = *(LAS f32x4*)(qf + d1) * rn;
            LAS bf16_t* qb = (LAS bf16_t*)(lds + GP_QB) + i * 136;
            *(LAS u32x2*)(qb + d0) = (u32x2){pk2(a[0], a[1]), pk2(a[2], a[3])}; *(LAS u32x2*)(qb + d1) = (u32x2){pk2(c[0], c[1]), pk2(c[2], c[3])};
            const float eg = EG[i]; const f32x4 ae = a * eg, ce = c * eg;
            *(u32x4*)(gout + GDNI_QD + img256(i, 2 * s + hh)) = (u32x4){pk2(ae[0], ae[1]), pk2(ae[2], ae[3]), pk2(ce[0], ce[1]), pk2(ce[2], ce[3])};
        } else {
            LAS float* kf = (LAS float*)(lds + GP_KF) + i * 132;
            const float rn = rsqrtf(SSK[i] + EPS);
            const f32x4 a = *(LAS f32x4*)(kf + d0) * rn, c = *(LAS f32x4*)(kf + d1) * rn;
            *(LAS f32x4*)(kf + d0) = a; *(LAS f32x4*)(kf + d1) = c;
            LAS bf16_t* kb = (LAS bf16_t*)(lds + GP_KB) + i * 136;
            *(LAS u32x2*)(kb + d0) = (u32x2){pk2(a[0], a[1]), pk2(a[2], a[3])}; *(LAS u32x2*)(kb + d1) = (u32x2){pk2(c[0], c[1]), pk2(c[2], c[3])};
        }
    }
    BAR_LDS();
    if (!(MODE & 4)) {
        const int sel = wave >> 2, mt = wave & 3, fr = lane & 15, fq = lane >> 4;
        const LAS unsigned char* abase = lds + (sel ? GP_QB : GP_KB) + (16 * mt + fr) * 272 + fq * 16;
        bf16x8 af[4];
#pragma unroll
        for (int ks = 0; ks < 4; ++ks) af[ks] = *(const LAS bf16x8*)(abase + ks * 64);
        f32x4 acc[4];
#pragma unroll
        for (int nt = 0; nt < 4; ++nt) { acc[nt] = (f32x4){0.f, 0.f, 0.f, 0.f};
            const LAS unsigned char* bbase = lds + GP_KB + (16 * nt + fr) * 272 + fq * 16;
#pragma unroll
            for (int ks = 0; ks < 4; ++ks) { const bf16x8 bfv = *(const LAS bf16x8*)(bbase + ks * 64); acc[nt] = __builtin_amdgcn_mfma_f32_16x16x32_bf16(af[ks], bfv, acc[nt], 0, 0, 0); } }
#pragma unroll
        for (int nt = 0; nt < 4; ++nt) { const int j = 16 * nt + fr; const float gj = GAM[j];
#pragma unroll
            for (int r = 0; r < 4; ++r) { const int i = 16 * mt + 4 * fq + r; const float dec = __expf(GAM[i] - gj);
                if (sel == 0) { const float a = (j < i) ? BETA[i] * acc[nt][r] * dec : 0.f;
                    if (nt == mt) ((LAS float*)(lds + GP_AM))[i * 68 + j] = a;
                    *((LAS bf16_t*)(lds + GP_AB) + i * 72 + j) = f2bf(-a); }
                else ((LAS float*)(lds + GP_QKM))[i * 64 + j] = (j <= i) ? acc[nt][r] * dec : 0.f; } }
    }
    BAR_LDS();
    if (wave == 7) {
        const int bb = lane >> 4, c = lane & 15;
        const LAS float* ab = (const LAS float*)(lds + GP_AM) + (16 * bb) * 68 + 16 * bb;
        float t[16];
#pragma unroll
        for (int i = 0; i < 16; ++i) {
            float s = (i == c) ? 1.f : 0.f;
#pragma unroll
            for (int j = 0; j < i; ++j) s -= ab[i * 68 + j] * t[j];
            t[i] = s;
        }
#pragma unroll
        for (int i = 0; i < 16; ++i) *((LAS bf16_t*)(lds + GP_TB) + (bb * 16 + i) * 16 + c) = f2bf(t[i]);
    } else if (!(MODE & 8)) {
        const float glast = GAM[63];
        for (int idx = tid; idx < 1024; idx += 448) {
            const int dk = idx & 127, chunk = idx >> 7, s = chunk >> 1, hh = chunk & 1;
            float v[8];
#pragma unroll
            for (int j = 0; j < 8; ++j) { const int i = 16 * s + 8 * (j >> 2) + 4 * hh + (j & 3); v[j] = ((const LAS float*)(lds + GP_KF))[i * 132 + dk] * __expf(glast - GAM[i]); }
            *(u32x4*)(gout + GDNI_KT + img128(dk, chunk)) = (u32x4){pk2(v[0], v[1]), pk2(v[2], v[3]), pk2(v[4], v[5]), pk2(v[6], v[7])};
        }
        for (int idx = tid; idx < 512; idx += 448) {
            const int i = idx >> 3, chunk = idx & 7, s = chunk >> 1, hh = chunk & 1, j0 = 16 * s + 4 * hh;
            const LAS float* qm = (const LAS float*)(lds + GP_QKM) + i * 64;
            const f32x4 a = *(const LAS f32x4*)(qm + j0), c = *(const LAS f32x4*)(qm + j0 + 8);
            *(u32x4*)(gout + GDNI_QK + img128(i, chunk)) = (u32x4){pk2(a[0], a[1]), pk2(a[2], a[3]), pk2(c[0], c[1]), pk2(c[2], c[3])};
        }
    }
    BAR_LDS();
    if (!(MODE & 1)) {
        const int fr = lane & 15, q = lane >> 4;
        f32x4 R[4][2]; unsigned Xp[4][2][2];
#pragma unroll
        for (int bk = 0; bk < 4; ++bk)
#pragma unroll
            for (int r = 0; r < 4; ++r) { const int i = 16 * bk + 4 * q + r; float bi = BETA[i]; if (wave >= 4) bi *= EG[i];
#pragma unroll
                for (int nt = 0; nt < 2; ++nt) { const int c = 32 * (wave & 3) + 16 * nt + fr;
                    R[bk][nt][r] = bi * ((const LAS float*)(lds + (wave < 4 ? GP_VF : GP_KF)))[i * 132 + c]; } }
        const u32x2 zz = (u32x2){0u, 0u};
#define RD_AB(row, col) (*(const LAS u32x2*)((const LAS bf16_t*)(lds + GP_AB) + (row) * 72 + (col)))
#define MK8(lo, hi) __builtin_bit_cast(bf16x8, (u32x4){(lo).x, (lo).y, (hi).x, (hi).y})
#pragma unroll
        for (int bk = 0; bk < 4; ++bk) {
            if (bk == 1) { const bf16x8 af = MK8(RD_AB(16 + fr, 4 * q), zz);
#pragma unroll
                for (int nt = 0; nt < 2; ++nt) { const u32x2 x0 = (u32x2){Xp[0][nt][0], Xp[0][nt][1]}; R[1][nt] = __builtin_amdgcn_mfma_f32_16x16x32_bf16(af, MK8(x0, zz), R[1][nt], 0, 0, 0); } }
            if (bk == 2) { const bf16x8 af = MK8(RD_AB(32 + fr, 4 * q), RD_AB(32 + fr, 16 + 4 * q));
#pragma unroll
                for (int nt = 0; nt < 2; ++nt) { const u32x2 x0 = (u32x2){Xp[0][nt][0], Xp[0][nt][1]}, x1 = (u32x2){Xp[1][nt][0], Xp[1][nt][1]};
                    R[2][nt] = __builtin_amdgcn_mfma_f32_16x16x32_bf16(af, MK8(x0, x1), R[2][nt], 0, 0, 0); } }
            if (bk == 3) { const bf16x8 af = MK8(RD_AB(48 + fr, 4 * q), RD_AB(48 + fr, 16 + 4 * q)), ag = MK8(RD_AB(48 + fr, 32 + 4 * q), zz);
#pragma unroll
                for (int nt = 0; nt < 2; ++nt) { const u32x2 x0 = (u32x2){Xp[0][nt][0], Xp[0][nt][1]}, x1 = (u32x2){Xp[1][nt][0], Xp[1][nt][1]}, x2 = (u32x2){Xp[2][nt][0], Xp[2][nt][1]};
                    R[3][nt] = __builtin_amdgcn_mfma_f32_16x16x32_bf16(af, MK8(x0, x1), R[3][nt], 0, 0, 0);
                    R[3][nt] = __builtin_amdgcn_mfma_f32_16x16x32_bf16(ag, MK8(x2, zz), R[3][nt], 0, 0, 0); } }
            const bf16x8 tf = MK8(*(const LAS u32x2*)((const LAS bf16_t*)(lds + GP_TB) + (bk * 16 + fr) * 16 + 4 * q), zz);
#pragma unroll
            for (int nt = 0; nt < 2; ++nt) {
                const u32x2 rp = (u32x2){pk2(R[bk][nt][0], R[bk][nt][1]), pk2(R[bk][nt][2], R[bk][nt][3])};
                R[bk][nt] = __builtin_amdgcn_mfma_f32_16x16x32_bf16(tf, MK8(rp, zz), (f32x4){0.f, 0.f, 0.f, 0.f}, 0, 0, 0);
                Xp[bk][nt][0] = pk2(R[bk][nt][0], R[bk][nt][1]); Xp[bk][nt][1] = pk2(R[bk][nt][2], R[bk][nt][3]);
            }
        }
#undef RD_AB
#undef MK8
        if (wave < 4) {
            unsigned char* wv = MODE ? P.ws + 502 * MiB + (size_t)(ci & 127) * 16384 : P.ws + WS_GDNWV + (size_t)ci * 16384;
#pragma unroll
            for (int bk = 0; bk < 4; ++bk)
#pragma unroll
                for (int nt = 0; nt < 2; ++nt)
                    *(u32x2*)(wv + ((((wave * 2 + (bk >> 1)) * 64 + (q & 1) * 32 + 16 * nt + fr) << 5) + (8 * (bk & 1) + 4 * (q >> 1)) * 2)) = (u32x2){Xp[bk][nt][0], Xp[bk][nt][1]};
        } else if (!(MODE & 16)) {
#pragma unroll
            for (int nt = 0; nt < 2; ++nt) { const int d = 32 * (wave - 4) + 16 * nt + fr, pos = swapb(d);
#pragma unroll
                for (int bk = 0; bk < 4; ++bk)
#pragma unroll
                    for (int r = 0; r < 4; ++r) { const int i = 16 * bk + 4 * q + r;
                        *(bf16_t*)(gout + GDNI_WK + img256(i, pos >> 3) + (pos & 7) * 2) = f2bf(-R[bk][nt][r]); } }
        }
    }
    {
        const float* nwp = P.in[I_GNW] + 16 * (tid & 7);
        const f32x4 n0 = *(const f32x4*)nwp, n1 = *(const f32x4*)(nwp + 4), n2 = *(const f32x4*)(nwp + 8), n3 = *(const f32x4*)(nwp + 12);
        u32x4 o0, o1;
        o0.x = pk2(siluf_(bflo(zr0.x)) * n0[0], siluf_(bfhi(zr0.x)) * n0[1]); o0.y = pk2(siluf_(bflo(zr0.y)) * n0[2], siluf_(bfhi(zr0.y)) * n0[3]);
        o0.z = pk2(siluf_(bflo(zr0.z)) * n1[0], siluf_(bfhi(zr0.z)) * n1[1]); o0.w = pk2(siluf_(bflo(zr0.w)) * n1[2], siluf_(bfhi(zr0.w)) * n1[3]);
        o1.x = pk2(siluf_(bflo(zr1.x)) * n2[0], siluf_(bfhi(zr1.x)) * n2[1]); o1.y = pk2(siluf_(bflo(zr1.y)) * n2[2], siluf_(bfhi(zr1.y)) * n2[3]);
        o1.z = pk2(siluf_(bflo(zr1.z)) * n3[0], siluf_(bfhi(zr1.z)) * n3[1]); o1.w = pk2(siluf_(bflo(zr1.w)) * n3[2], siluf_(bfhi(zr1.w)) * n3[3]);
        u32x4* zd = (u32x4*)((MODE ? P.ws + 504 * MiB + (size_t)(ci & 127) * 16384 : P.ws + WS_ZS + (size_t)ci * 16384) + (size_t)(tid >> 3) * 256 + 32 * (tid & 7));
        zd[0] = o0; zd[1] = o1;
    }
  }
#undef GP_LOAD
}
DI bf16x8 pack_acc(const f32x16& x, int s) {
    u32x4 p;
    if (s == 0) { p.x = pk2(x[0], x[1]); p.y = pk2(x[2], x[3]); p.z = pk2(x[4], x[5]); p.w = pk2(x[6], x[7]); }
    else        { p.x = pk2(x[8], x[9]); p.y = pk2(x[10], x[11]); p.z = pk2(x[12], x[13]); p.w = pk2(x[14], x[15]); }
    return __builtin_bit_cast(bf16x8, p);
}
#ifndef SCAN_PRIO
#define SCAN_PRIO 0
#endif
constexpr int SC_STG0 = 0, SC_STG1 = 57344, SC_OB0 = 114688, SC_OB1 = 132096, SC_NW = 149504;
#define MFMA32(a, b, c) __builtin_amdgcn_mfma_f32_32x32x16_bf16((a), (b), (c), 0, 0, 0)

template <int MODE>
DI void gdn_scan_block(const Params& P, LAS unsigned char* lds, int gi) {
    int tid = threadIdx.x; asm volatile("" : "+v"(tid)); const int lane = tid & 63, wave = __builtin_amdgcn_readfirstlane(tid >> 6);
    const int h = gi & 3, b = gi >> 2, ci0 = gi * NCHUNK, Rb = b * TSEQ;
    const unsigned char* stg = P.ws + WS_GDNI + (size_t)ci0 * GDNI_STG;
    const bf16_t* proj = (const bf16_t*)(P.ws + WS_BIG);
    if (wave < 4) {
        const int r = lane & 31, hh = lane >> 5, w = wave;
#if SCAN_PRIO
        __builtin_amdgcn_s_setprio(SCAN_PRIO);
#endif
        f32x16 S[4];
#pragma unroll
        for (int T = 0; T < 4; ++T) S[T] = (f32x16){0.f, 0.f, 0.f, 0.f, 0.f, 0.f, 0.f, 0.f, 0.f, 0.f, 0.f, 0.f, 0.f, 0.f, 0.f, 0.f};
        u32x4 wvn[2][2]; float gtn;
        {
            const unsigned char* wv = P.ws + WS_GDNWV + (size_t)ci0 * 16384;
#pragma unroll
            for (int mt = 0; mt < 2; ++mt) { const u32x4* src = (const u32x4*)(wv + (((w * 2 + mt) * 64 + lane) << 5)); wvn[mt][0] = src[0]; wvn[mt][1] = src[1]; }
            gtn = ((const float*)(P.ws + WS_GT))[ci0];
        }
        BAR_LDS();
        for (int n = 0; n < NCHUNK; ++n) {
            const int cur = (n & 1) ? SC_STG1 : SC_STG0, ob = (n & 1) ? SC_OB1 : SC_OB0;
            if (MODE & 1) { BAR_LDS(); continue; }
            f32x16 U[2], O[2];
            const float gt = gtn;
#pragma unroll
            for (int mt = 0; mt < 2; ++mt) {
                const u32x4 a = wvn[mt][0], c = wvn[mt][1];
                U[mt][0] = bflo(a.x); U[mt][1] = bfhi(a.x); U[mt][2] = bflo(a.y); U[mt][3] = bfhi(a.y); U[mt][4] = bflo(a.z); U[mt][5] = bfhi(a.z); U[mt][6] = bflo(a.w); U[mt][7] = bfhi(a.w);
                U[mt][8] = bflo(c.x); U[mt][9] = bfhi(c.x); U[mt][10] = bflo(c.y); U[mt][11] = bfhi(c.y); U[mt][12] = bflo(c.z); U[mt][13] = bfhi(c.z); U[mt][14] = bflo(c.w); U[mt][15] = bfhi(c.w);
            }
#define RD_WK(ks, mt) (*(const LAS bf16x8*)(lds + cur + GDNI_WK + img256(32 * (mt) + r, 2 * (ks) + hh)))
#define RD_QD(ks, mt) (*(const LAS bf16x8*)(lds + cur + GDNI_QD + img256(32 * (mt) + r, 2 * (ks) + hh)))
#define RD_QK(ks, mt) (*(const LAS bf16x8*)(lds + cur + GDNI_QK + img128(32 * (mt) + r, 2 * (ks) + hh)))
#define RD_KT(ks, T)  (*(const LAS bf16x8*)(lds + cur + GDNI_KT + img128(32 * (T) + r, 2 * (ks) + hh)))
#define SCHED_FENCE() __builtin_amdgcn_sched_barrier(0)
#define RD_UO(F, ks) do { F[0] = RD_WK(ks, 0); F[1] = RD_WK(ks, 1); F[2] = RD_QD(ks, 0); F[3] = RD_QD(ks, 1); } while (0)
#define MM_UO(F, ks) do { const bf16x8 sb_ = pack_acc(S[(ks) >> 1], (ks) & 1); U[0] = MFMA32(F[0], sb_, U[0]); U[1] = MFMA32(F[1], sb_, U[1]); O[0] = MFMA32(F[2], sb_, O[0]); O[1] = MFMA32(F[3], sb_, O[1]); } while (0)
            bf16x8 FA[4], FB[4];
            O[0] = (f32x16){0.f, 0.f, 0.f, 0.f, 0.f, 0.f, 0.f, 0.f, 0.f, 0.f, 0.f, 0.f, 0.f, 0.f, 0.f, 0.f}; O[1] = O[0];
            RD_UO(FA, 0); RD_UO(FB, 1); SCHED_FENCE();
            MM_UO(FA, 0); SCHED_FENCE(); RD_UO(FA, 2); SCHED_FENCE();
            MM_UO(FB, 1); SCHED_FENCE(); RD_UO(FB, 3); SCHED_FENCE();
            MM_UO(FA, 2); SCHED_FENCE(); RD_UO(FA, 4); SCHED_FENCE();
            MM_UO(FB, 3); SCHED_FENCE(); RD_UO(FB, 5); SCHED_FENCE();
            MM_UO(FA, 4); SCHED_FENCE(); RD_UO(FA, 6); SCHED_FENCE();
            MM_UO(FB, 5); SCHED_FENCE(); RD_UO(FB, 7); SCHED_FENCE();
            MM_UO(FA, 6); SCHED_FENCE();
            FA[0] = RD_QK(0, 0); FA[1] = RD_QK(0, 1); FA[2] = RD_QK(1, 0); FA[3] = RD_QK(1, 1); SCHED_FENCE();
            MM_UO(FB, 7); SCHED_FENCE();
            FB[0] = RD_QK(2, 1); FB[1] = RD_QK(3, 1); FB[2] = RD_KT(0, 0); FB[3] = RD_KT(1, 0); SCHED_FENCE();
            bf16x8 Ub[4];
#pragma unroll
            for (int k = 0; k < 4; ++k) Ub[k] = pack_acc(U[k >> 1], k & 1);
            if (n + 1 < NCHUNK) {
                const unsigned char* wv = P.ws + WS_GDNWV + (size_t)(ci0 + n + 1) * 16384;
#pragma unroll
                for (int mt = 0; mt < 2; ++mt) { const u32x4* src = (const u32x4*)(wv + (((w * 2 + mt) * 64 + lane) << 5)); wvn[mt][0] = src[0]; wvn[mt][1] = src[1]; }
                gtn = ((const float*)(P.ws + WS_GT))[ci0 + n + 1];
            }
            O[0] = MFMA32(FA[0], Ub[0], O[0]); O[1] = MFMA32(FA[1], Ub[0], O[1]); O[0] = MFMA32(FA[2], Ub[1], O[0]); O[1] = MFMA32(FA[3], Ub[1], O[1]); SCHED_FENCE();
            FA[0] = RD_KT(2, 0); FA[1] = RD_KT(3, 0); FA[2] = RD_KT(0, 1); FA[3] = RD_KT(1, 1); SCHED_FENCE();
            S[0] = S[0] * gt;
            O[1] = MFMA32(FB[0], Ub[2], O[1]); O[1] = MFMA32(FB[1], Ub[3], O[1]); S[0] = MFMA32(FB[2], Ub[0], S[0]); S[0] = MFMA32(FB[3], Ub[1], S[0]); SCHED_FENCE();
            FB[0] = RD_KT(2, 1); FB[1] = RD_KT(3, 1); FB[2] = RD_KT(0, 2); FB[3] = RD_KT(1, 2); SCHED_FENCE();
            S[1] = S[1] * gt;
            S[0] = MFMA32(FA[0], Ub[2], S[0]); S[0] = MFMA32(FA[1], Ub[3], S[0]); S[1] = MFMA32(FA[2], Ub[0], S[1]); S[1] = MFMA32(FA[3], Ub[1], S[1]); SCHED_FENCE();
            FA[0] = RD_KT(2, 2); FA[1] = RD_KT(3, 2); FA[2] = RD_KT(0, 3); FA[3] = RD_KT(1, 3); SCHED_FENCE();
            S[2] = S[2] * gt;
            S[1] = MFMA32(FB[0], Ub[2], S[1]); S[1] = MFMA32(FB[1], Ub[3], S[1]); S[2] = MFMA32(FB[2], Ub[0], S[2]); S[2] = MFMA32(FB[3], Ub[1], S[2]); SCHED_FENCE();
            FB[0] = RD_KT(2, 3); FB[1] = RD_KT(3, 3); SCHED_FENCE();
            S[3] = S[3] * gt;
            S[2] = MFMA32(FA[0], Ub[2], S[2]); S[2] = MFMA32(FA[1], Ub[3], S[2]); S[3] = MFMA32(FA[2], Ub[0], S[3]); S[3] = MFMA32(FA[3], Ub[1], S[3]); SCHED_FENCE();
#pragma unroll
            for (int mt = 0; mt < 2; ++mt)
#pragma unroll
                for (int e = 0; e < 16; ++e) { const int i = 32 * mt + (e & 3) + 8 * (e >> 2) + 4 * hh;
                    *(LAS bf16_t*)(lds + ob + i * 272 + (32 * w + r) * 2) = f2bf(O[mt][e]); }
            S[3] = MFMA32(FB[0], Ub[2], S[3]); S[3] = MFMA32(FB[1], Ub[3], S[3]);
#undef RD_UO
#undef MM_UO
#undef RD_WK
#undef RD_QD
#undef RD_QK
#undef RD_KT
#undef SCHED_FENCE
            BAR_LDS();
        }
#if SCAN_PRIO
        __builtin_amdgcn_s_setprio(0);
#endif
        if (MODE == 0) {
        float* so = P.out + O_PGDN + (size_t)gi * 128 * 128;
#pragma unroll
        for (int T = 0; T < 4; ++T)
#pragma unroll
            for (int e = 0; e < 16; ++e) so[(32 * T + (e & 3) + 8 * (e >> 2) + 4 * hh) * 128 + 32 * w + r] = S[T][e];
        } else { float acc_ = 0.f; for (int T = 0; T < 4; ++T) acc_ += S[T][0]; if (acc_ == 123.456f) P.out[0] = acc_; }
    } else {
        bf16_t* mix = (bf16_t*)(P.ws + WS_MIX);
        const int t2 = tid - 256; int i = t2 >> 2, qd = t2 & 3;
        unsigned lo16 = (unsigned)t2 * 16u;
        asm volatile("" : "+v"(lo16));
        u32x4 nxA[14], nxB[14], zA[4], zB[4];
#define LOADNX(X, c_) do { _Pragma("unroll") for (int k = 0; k < 14; ++k) X[k] = *(const u32x4*)(stg + (size_t)(c_) * GDNI_STG + k * 4096 + lo16); } while (0)
#define WRITENX(X, off_) do { _Pragma("unroll") for (int k = 0; k < 14; ++k) *(LAS u32x4*)(lds + (off_) + k * 4096 + lo16) = X[k]; } while (0)
#define LOADZ(Z, c_) do { const u32x4* zp_ = (const u32x4*)(P.ws + WS_ZS + (size_t)(ci0 + ((MODE & 8) ? ((c_) & 3) : (c_))) * 16384 + i * 256 + qd * 64); _Pragma("unroll") for (int k = 0; k < 4; ++k) Z[k] = zp_[k]; } while (0)
#define POST(Z, c_, ob_) do { \
            float ssq = 0.f; \
            _Pragma("unroll") for (int k = 0; k < 4; ++k) { const u32x4 ov = *(const LAS u32x4*)(lds + (ob_) + i * 272 + qd * 64 + k * 16); \
                const float a0 = bflo(ov.x), a1 = bfhi(ov.x), a2 = bflo(ov.y), a3 = bfhi(ov.y), a4 = bflo(ov.z), a5 = bfhi(ov.z), a6 = bflo(ov.w), a7 = bfhi(ov.w); \
                ssq += (a0 * a0 + a1 * a1) + (a2 * a2 + a3 * a3) + (a4 * a4 + a5 * a5) + (a6 * a6 + a7 * a7); } \
            ssq += __shfl_xor(ssq, 1); ssq += __shfl_xor(ssq, 2); \
            const float rstd = rsqrtf(ssq * (1.0f / 128.0f) + EPS); \
            u32x4* mp = (u32x4*)(mix + (size_t)(Rb + (c_) * 64 + i) * D + h * 128 + 32 * qd); \
            _Pragma("unroll") for (int k = 0; k < 4; ++k) { const u32x4 ov = *(const LAS u32x4*)(lds + (ob_) + i * 272 + qd * 64 + k * 16); \
                const float y0 = bflo(ov.x) * rstd * bflo(Z[k].x), y1 = bfhi(ov.x) * rstd * bfhi(Z[k].x); \
                const float y2 = bflo(ov.y) * rstd * bflo(Z[k].y), y3 = bfhi(ov.y) * rstd * bfhi(Z[k].y); \
                const float y4 = bflo(ov.z) * rstd * bflo(Z[k].z), y5 = bfhi(ov.z) * rstd * bfhi(Z[k].z); \
                const float y6 = bflo(ov.w) * rstd * bflo(Z[k].w), y7 = bfhi(ov.w) * rstd * bfhi(Z[k].w); \
                const u32x4 res_ = (u32x4){pk2(y0, y1), pk2(y2, y3), pk2(y4, y5), pk2(y6, y7)}; if (MODE == 0) mp[k] = res_; else if (res_.x == 0x12345678u && res_.y == 0x9abcdef0u) mp[k] = res_; asm volatile("" ::: "memory"); } } while (0)
        LOADNX(nxA, 0); LOADNX(nxB, 1);
        __builtin_amdgcn_sched_barrier(0);
        WRITENX(nxA, SC_STG0); WRITENX(nxB, SC_STG1);
        __builtin_amdgcn_sched_barrier(0);
        LOADZ(zA, 0); LOADZ(zB, 1); LOADNX(nxA, 2); LOADNX(nxB, 3);
        BAR_LDS();
        for (int n = 0; n < NCHUNK; n += 2) {
            asm volatile("" : "+v"(i), "+v"(qd), "+v"(lo16));
            BAR_LDS();
            if (!(MODE & 2)) { POST(zA, n, SC_OB0); }
            if (n + 2 < NCHUNK) { if (!(MODE & 2)) LOADZ(zA, n + 2); if (!(MODE & 4)) WRITENX(nxA, SC_STG0); }
            if (n + 4 < NCHUNK && !(MODE & 4)) LOADNX(nxA, n + 4);
            BAR_LDS();
            if (!(MODE & 2)) { POST(zB, n + 1, SC_OB1); }
            if (n + 3 < NCHUNK) { if (!(MODE & 2)) LOADZ(zB, n + 3); if (!(MODE & 4)) WRITENX(nxB, SC_STG1); }
            if (n + 5 < NCHUNK && !(MODE & 4)) LOADNX(nxB, n + 5);
        }
#undef LOADNX
#undef WRITENX
#undef LOADZ
#undef POST
        if (MODE == 0) for (int idx = t2; idx < 3 * 384; idx += 256) { const int j = idx / 384, c = idx % 384, col = (c >> 7) * 512 + h * 128 + (c & 127);
            P.out[O_PGDNCONV + ((size_t)b * 3 + j) * 1536 + col] = bf2f(proj[(size_t)(Rb + TSEQ - 3 + j) * NIN + col]); }
    }
}
constexpr int LR_CW = 0;
constexpr int LR_CAR = 2048;
constexpr int LR_WL = 10240, LR_WSZ = 9216, LR_WB = 84992;
DI void lru_block(const Params& P, LAS unsigned char* lds, int li) {
    int tid = threadIdx.x; asm volatile("" : "+v"(tid)); const int lane = tid & 63, wave = __builtin_amdgcn_readfirstlane(tid >> 6);
    const int nb = li & 7, b = li >> 3, Rb = b * TSEQ;
    const bf16_t* proj = (const bf16_t*)(P.ws + WS_BIG);
    bf16_t* mix = (bf16_t*)(P.ws + WS_MIX);
    const int fr = lane & 15, fq = lane >> 4;
    LAS float* CW = (LAS float*)(lds + LR_CW);
    LAS float* XT = (LAS float*)(lds + LR_WL + wave * LR_WSZ);
    LAS bf16_t* GT = (LAS bf16_t*)(lds + LR_WL + wave * LR_WSZ + 4352);
    LAS bf16_t* YT = (LAS bf16_t*)(lds + LR_WL + wave * LR_WSZ + 6656);
    if (tid < 256) CW[tid] = P.in[I_CONVL][(tid >> 6) * 512 + nb * 64 + (tid & 63)]; else if (tid < 320) CW[tid] = P.in[I_CONVLB][nb * 64 + (tid - 256)];
    float cba[4], cbx[4], csp[4];
#pragma unroll
    for (int ct = 0; ct < 4; ++ct) { const int oc = 16 * ct + fr;
        cba[ct] = P.in[I_LBA][nb * 64 + oc]; cbx[ct] = P.in[I_LBX][nb * 64 + oc]; csp[ct] = 8.0f * softplusf_(-P.in[I_LLAM][nb * 64 + oc]); }
    { const int gsel = wave >> 2, ct = wave & 3, oc = 16 * ct + fr; const float* W = P.in[gsel ? I_LWX : I_LWA] + (size_t)nb * 4096;
#pragma unroll
      for (int ks = 0; ks < 2; ++ks) { unsigned pw[4];
#pragma unroll
          for (int j = 0; j < 4; ++j) { const int i0 = 32 * ks + 8 * fq + 2 * j; pw[j] = pk2(W[i0 * 64 + oc], W[(i0 + 1) * 64 + oc]); }
          *(LAS u32x4*)(lds + LR_WB + (((gsel * 4 + ct) * 2 + ks) * 64 + lane) * 16) = (u32x4){pw[0], pw[1], pw[2], pw[3]}; } }
    float hb[4] = {0.f, 0.f, 0.f, 0.f};
    u32x4 xin[4][2], gin[2];
#define LR_LOAD(it_) do { const int tb_ = (it_) * 128 + 16 * wave; \
        _Pragma("unroll") for (int j = 0; j < 4; ++j) { const int t = tb_ + fr + j - 3; \
            _Pragma("unroll") for (int ks = 0; ks < 2; ++ks) { xin[j][ks] = (u32x4){0u, 0u, 0u, 0u}; \
                if (t >= 0) xin[j][ks] = *(const u32x4*)(proj + (size_t)(Rb + t) * NIN + 2560 + nb * 64 + 32 * ks + 8 * fq); } } \
        _Pragma("unroll") for (int k = 0; k < 2; ++k) { const int p_ = lane + 64 * k; gin[k] = *(const u32x4*)(proj + (size_t)(Rb + tb_ + (p_ >> 3)) * NIN + 2048 + nb * 64 + 8 * (p_ & 7)); } } while (0)
    LR_LOAD(0);
    __syncthreads();
    for (int it = 0; it < TSEQ / 128; ++it) {
        const int tb = it * 128 + 16 * wave, par = it & 1;
        float xr[2][8];
#pragma unroll
        for (int ks = 0; ks < 2; ++ks) {
            const LAS float* cwp = CW + 32 * ks + 8 * fq;
            const f32x4 b0 = *(const LAS f32x4*)(cwp + 256), b1 = *(const LAS f32x4*)(cwp + 260);
            float acc8[8] = {b0[0], b0[1], b0[2], b0[3], b1[0], b1[1], b1[2], b1[3]};
#pragma unroll
            for (int j = 0; j < 4; ++j) { const f32x4 w0 = *(const LAS f32x4*)(cwp + 64 * j), w1 = *(const LAS f32x4*)(cwp + 64 * j + 4); const u32x4 x = xin[j][ks];
                acc8[0] += w0[0] * bflo(x.x); acc8[1] += w0[1] * bfhi(x.x); acc8[2] += w0[2] * bflo(x.y); acc8[3] += w0[3] * bfhi(x.y);
                acc8[4] += w1[0] * bflo(x.z); acc8[5] += w1[1] * bfhi(x.z); acc8[6] += w1[2] * bflo(x.w); acc8[7] += w1[3] * bfhi(x.w); }
#pragma unroll
            for (int e = 0; e < 8; ++e) xr[ks][e] = acc8[e];
        }
        const u32x4 g0 = gin[0], g1 = gin[1];
        if (it + 1 < TSEQ / 128) LR_LOAD(it + 1);
#pragma unroll
        for (int ks = 0; ks < 2; ++ks) { LAS float* d = XT + fr * 68 + 32 * ks + 8 * fq;
            *(LAS f32x4*)d = (f32x4){xr[ks][0], xr[ks][1], xr[ks][2], xr[ks][3]}; *(LAS f32x4*)(d + 4) = (f32x4){xr[ks][4], xr[ks][5], xr[ks][6], xr[ks][7]}; }
        *(LAS u32x4*)(GT + (lane >> 3) * 72 + 8 * (lane & 7)) = g0; *(LAS u32x4*)(GT + (8 + (lane >> 3)) * 72 + 8 * (lane & 7)) = g1;
        bf16x8 af[2];
#pragma unroll
        for (int ks = 0; ks < 2; ++ks) af[ks] = __builtin_bit_cast(bf16x8, (u32x4){pk2(xr[ks][0], xr[ks][1]), pk2(xr[ks][2], xr[ks][3]), pk2(xr[ks][4], xr[ks][5]), pk2(xr[ks][6], xr[ks][7])});
        f32x4 ra[4], ia[4];
#pragma unroll
        for (int ct = 0; ct < 4; ++ct) { ra[ct] = (f32x4){0.f, 0.f, 0.f, 0.f}; ia[ct] = ra[ct];
#pragma unroll
            for (int ks = 0; ks < 2; ++ks) { const bf16x8 wa_ = *(const LAS bf16x8*)(lds + LR_WB + (((0 * 4 + ct) * 2 + ks) * 64 + lane) * 16), wx_ = *(const LAS bf16x8*)(lds + LR_WB + (((1 * 4 + ct) * 2 + ks) * 64 + lane) * 16);
                ra[ct] = __builtin_amdgcn_mfma_f32_16x16x32_bf16(af[ks], wa_, ra[ct], 0, 0, 0); ia[ct] = __builtin_amdgcn_mfma_f32_16x16x32_bf16(af[ks], wx_, ia[ct], 0, 0, 0); } }
        asm volatile("s_waitcnt lgkmcnt(0)" ::: "memory");
        float hl[4][4], pl[4][4], Ae[4], Be[4];
#pragma unroll
        for (int ct = 0; ct < 4; ++ct) {
            float h = 0.f, pr = 1.f;
#pragma unroll
            for (int r = 0; r < 4; ++r) {
                const float rg = sigmoidf_(ra[ct][r] + cba[ct]), ig = sigmoidf_(ia[ct][r] + cbx[ct]);
                const float a = __expf(-rg * csp[ct]);
                const float bco = __builtin_amdgcn_sqrtf(fmaxf(fmaf(-a, a, 1.0f), 0.f)) * ig * XT[(4 * fq + r) * 68 + 16 * ct + fr];
                h = a * h + bco; pr = pr * a; hl[ct][r] = h; pl[ct][r] = pr;
            }
            float A = pr, B = h;
            { const float pa = __shfl_up(A, 16), pb = __shfl_up(B, 16); if (fq >= 1) { B = A * pb + B; A = A * pa; } }
            { const float pa = __shfl_up(A, 32), pb = __shfl_up(B, 32); if (fq >= 2) { B = A * pb + B; A = A * pa; } }
            const float ea = __shfl_up(A, 16), eb = __shfl_up(B, 16);
            Ae[ct] = (fq >= 1) ? ea : 1.f; Be[ct] = (fq >= 1) ? eb : 0.f;
            if (fq == 3) { LAS float* c = (LAS float*)(lds + LR_CAR) + ((par * 8 + wave) * 2) * 64 + 16 * ct + fr; c[0] = A; c[64] = B; }
        }
        BAR_LDS();
        float hin[4];
#pragma unroll
        for (int ct = 0; ct < 4; ++ct) {
            float h = hb[ct]; hin[ct] = h;
#pragma unroll
            for (int v = 0; v < 8; ++v) { const LAS float* c = (const LAS float*)(lds + LR_CAR) + ((par * 8 + v) * 2) * 64 + 16 * ct + fr;
                h = c[0] * h + c[64]; if (v + 1 == wave) hin[ct] = h; }
            hb[ct] = h;
        }
#pragma unroll
        for (int ct = 0; ct < 4; ++ct)
#pragma unroll
            for (int r = 0; r < 4; ++r) {
                const float hw = hl[ct][r] + pl[ct][r] * Be[ct], pw = pl[ct][r] * Ae[ct];
                const float hfin = hw + pw * hin[ct];
                const float g = bf2f(GT[(4 * fq + r) * 72 + 16 * ct + fr]);
                YT[(4 * fq + r) * 72 + 16 * ct + fr] = f2bf(gelu_tanh(g) * hfin);
            }
        asm volatile("s_waitcnt lgkmcnt(0)" ::: "memory");
#pragma unroll
        for (int k = 0; k < 2; ++k) { const int p_ = lane + 64 * k;
            *(u32x4*)(mix + (size_t)(Rb + tb + (p_ >> 3)) * D + 512 + nb * 64 + 8 * (p_ & 7)) = *(const LAS u32x4*)(YT + (p_ >> 3) * 72 + 8 * (p_ & 7)); }
    }
#undef LR_LOAD
    if (wave == 0 && fq == 0) {
#pragma unroll
        for (int ct = 0; ct < 4; ++ct) P.out[O_PLRU + (size_t)b * 512 + nb * 64 + 16 * ct + fr] = hb[ct];
    }
    if (tid < 192) { const int j = tid >> 6, c = tid & 63; P.out[O_PLRUCONV + ((size_t)b * 3 + j) * 512 + nb * 64 + c] = bf2f(proj[(size_t)(Rb + TSEQ - 3 + j) * NIN + 2560 + nb * 64 + c]); }
}

DI void sample_ab_block(const Params& P, LAS unsigned char* lds, int sb) {
    int tid = threadIdx.x; asm volatile("" : "+v"(tid)); const int lane = tid & 63, wave = __builtin_amdgcn_readfirstlane(tid >> 6);
    const bf16_t* proj = (const bf16_t*)(P.ws + WS_BIG);
    bf16_t* mix = (bf16_t*)(P.ws + WS_MIX);
    LAS float* xr = (LAS float*)lds;
    {
        const int c = tid;
        const float* cw = P.in[I_CONVL];
        const float w0 = cw[c], w1 = cw[512 + c], w2 = cw[1024 + c], w3 = cw[1536 + c], cb = P.in[I_CONVLB][c];
#pragma unroll
        for (int k = 0; k < 2; ++k) {
            const int s = 2 * sb + k, r = MP + s;
            const float* buf = P.in[I_SLRUCONV] + (size_t)s * 3 * 512;
            const float xn = bf2f(proj[(size_t)r * NIN + 2560 + c]);
            const float b0 = buf[c], b1 = buf[512 + c], b2 = buf[1024 + c];
            xr[k * 512 + c] = w0 * b0 + w1 * b1 + w2 * b2 + w3 * xn + cb;
            float* co = P.out + O_SLRUCONV + (size_t)s * 3 * 512;
            co[c] = b1; co[512 + c] = b2; co[1024 + c] = xn;
        }
        __syncthreads();
        const int nb = c >> 6, oc = c & 63;
        const float* wa = P.in[I_LWA] + (size_t)nb * 4096 + oc; const float* wx = P.in[I_LWX] + (size_t)nb * 4096 + oc;
        float ra0 = P.in[I_LBA][c], ia0 = P.in[I_LBX][c], ra1 = ra0, ia1 = ia0;
#pragma unroll 1
        for (int i0 = 0; i0 < 64; i0 += 32) {
            float va[32], vx[32];
#pragma unroll
            for (int i = 0; i < 32; ++i) { va[i] = wa[(i0 + i) * 64]; vx[i] = wx[(i0 + i) * 64]; }
            __builtin_amdgcn_sched_barrier(0);
#pragma unroll
            for (int i = 0; i < 32; ++i) { const float x0 = xr[nb * 64 + i0 + i], x1 = xr[512 + nb * 64 + i0 + i];
                ra0 += x0 * va[i]; ia0 += x0 * vx[i]; ra1 += x1 * va[i]; ia1 += x1 * vx[i]; }
        }
        const float sp = softplusf_(-P.in[I_LLAM][c]);
#pragma unroll
        for (int k = 0; k < 2; ++k) {
            const int s = 2 * sb + k, r = MP + s;
            const float rg = sigmoidf_(k ? ra1 : ra0), ig = sigmoidf_(k ? ia1 : ia0);
            const float la = -8.0f * rg * sp;
            const float a = __expf(la), bb = sqrtf(-expm1f(2.0f * la)) * ig * xr[k * 512 + c];
            const float hnew = a * P.in[I_SLRU][(size_t)s * 512 + c] + bb;
            P.out[O_SLRU + (size_t)s * 512 + c] = hnew;
            mix[(size_t)r * D + 512 + c] = f2bf(gelu_tanh(bf2f(proj[(size_t)r * NIN + 2048 + c])) * hnew);
        }
    }
    __syncthreads();
    {
        const int k = wave >> 2, h = wave & 3, s = 2 * sb + k, r = MP + s;
        LAS float* qk = (LAS float*)(lds + 4096) + wave * 256;
        const float* buf = P.in[I_SGDNCONV] + (size_t)s * 3 * 1536; const float* cw = P.in[I_CONVG];
        float* co = P.out + O_SGDNCONV + (size_t)s * 3 * 1536;
        float val[3][2];
#pragma unroll
        for (int wh = 0; wh < 3; ++wh)
#pragma unroll
            for (int p = 0; p < 2; ++p) { const int col = wh * 512 + h * 128 + 64 * p + lane;
                const float xn = bf2f(proj[(size_t)r * NIN + col]);
                const float b0 = buf[col], b1 = buf[1536 + col], b2 = buf[3072 + col];
                val[wh][p] = siluf_(cw[col] * b0 + cw[1536 + col] * b1 + cw[3072 + col] * b2 + cw[4608 + col] * xn);
                co[col] = b1; co[1536 + col] = b2; co[3072 + col] = xn; }
        const float ssq = wave_sum(val[0][0] * val[0][0] + val[0][1] * val[0][1]), ssk = wave_sum(val[1][0] * val[1][0] + val[1][1] * val[1][1]);
        const float rq = rsqrtf(ssq + EPS) * 0.08838834764831845f, rk = rsqrtf(ssk + EPS);
        qk[lane] = val[0][0] * rq; qk[64 + lane] = val[0][1] * rq; qk[128 + lane] = val[1][0] * rk; qk[192 + lane] = val[1][1] * rk;
        const float* BA = (const float*)(P.ws + WS_BA) + (size_t)r * 8;
        const float beta = sigmoidf_(BA[h]);
        const float eg = __expf(-__expf(P.in[I_ALOG][h]) * softplusf_(BA[4 + h] + P.in[I_DTB][h]));
        asm volatile("s_waitcnt lgkmcnt(0)" ::: "memory");
        const float* S0 = P.in[I_SGDN] + ((size_t)s * 4 + h) * 16384; float* S1 = P.out + O_SGDN + ((size_t)s * 4 + h) * 16384;
        float pr0 = 0.f, pr1 = 0.f, qs0 = 0.f, qs1 = 0.f;
#pragma unroll 1
        for (int d0 = 0; d0 < 128; d0 += 32) {
            const float* sp = S0 + (size_t)d0 * 128 + lane;
            float a[32], bq[32];
#pragma unroll
            for (int d = 0; d < 32; ++d) { a[d] = sp[d * 128]; bq[d] = sp[d * 128 + 64]; }
#pragma unroll
            for (int d = 0; d < 32; ++d) { const float kd = qk[128 + d0 + d], qd_ = qk[d0 + d]; pr0 += kd * a[d]; pr1 += kd * bq[d]; qs0 += qd_ * a[d]; qs1 += qd_ * bq[d]; }
        }
        const float qkdot = wave_sum(qk[lane] * qk[128 + lane] + qk[64 + lane] * qk[192 + lane]);
        const float dv0 = beta * (val[2][0] - eg * pr0), dv1 = beta * (val[2][1] - eg * pr1);
        const float o0 = eg * qs0 + qkdot * dv0, o1 = eg * qs1 + qkdot * dv1;
#pragma unroll 1
        for (int d0 = 0; d0 < 128; d0 += 32) {
            const float* sp = S0 + (size_t)d0 * 128 + lane; float* dp = S1 + (size_t)d0 * 128 + lane;
            float a[32], bq[32];
#pragma unroll
            for (int d = 0; d < 32; ++d) { a[d] = sp[d * 128]; bq[d] = sp[d * 128 + 64]; }
#pragma unroll
            for (int d = 0; d < 32; ++d) { const float kd = qk[128 + d0 + d]; dp[d * 128] = a[d] * eg + kd * dv0; dp[d * 128 + 64] = bq[d] * eg + kd * dv1; }
        }
        const float rstd = rsqrtf(wave_sum(o0 * o0 + o1 * o1) * (1.0f / 128.0f) + EPS);
#pragma unroll
        for (int p = 0; p < 2; ++p) { const int e = 64 * p + lane;
            const float z = bf2f(proj[(size_t)r * NIN + 1536 + h * 128 + e]);
            mix[(size_t)r * D + h * 128 + e] = f2bf((p ? o1 : o0) * rstd * P.in[I_GNW][e] * siluf_(z)); }
    }
}
#ifndef AT_KVREP
#define AT_KVREP 1
#endif
constexpr int AT_K = 0, AT_V = 32768, AT_O = 65536, AT_ORS = 136;
typedef short s16x4 __attribute__((ext_vector_type(4)));
DI int at_vst(int k, int c) { const int kk = (k & ~0xC) | ((k & 4) << 1) | ((k & 8) >> 1); return ((kk >> 3) * 2 + (c >> 5)) * 512 + ((kk & 7) * 32 + (c & 31)) * 2; }
DI float max3_(float a, float b, float c) { float d; asm("v_max3_f32 %0, %1, %2, %3" : "=v"(d) : "v"(a), "v"(b), "v"(c)); return d; }
DI float alibi_slope(int hq) { return exp2f(-0.5f * (float)(hq + 1)); }
template <int MODE>
DI void attn_prompt_run(const Params& P, LAS unsigned char* lds, int first, int cnt) {
    int tid0 = threadIdx.x; asm volatile("" : "+v"(tid0)); const int wave = __builtin_amdgcn_readfirstlane(tid0 >> 6);
    const bf16_t* qkv = (const bf16_t*)(P.ws + WS_BIG);
    bf16_t* att = (bf16_t*)(P.ws + WS_MIX);
    u32x4 kraw[4], vraw[4];
#define AT_LOADKV(it_) do { const int kvh_ = (it_) & 3, qb_ = ((it_) >> 2) & 15, b_ = (it_) >> 6, Rq_ = b_ * TSEQ + qb_ * 128; \
        _Pragma("unroll") for (int rep = 0; rep < 4; ++rep) { const int idx = tid0 + 512 * rep; \
            { const int row = idx >> 3, ch = idx & 7; kraw[rep] = (u32x4){0u, 0u, 0u, 0u}; \
              if (qb_ > 0 || row >= 128) kraw[rep] = *(const u32x4*)(qkv + (size_t)(Rq_ - 128 + row) * NQKV + 1024 + kvh_ * 64 + 8 * ch); \
              vraw[rep] = (u32x4){0u, 0u, 0u, 0u}; \
              if (qb_ > 0 || row >= 128) vraw[rep] = *(const u32x4*)(qkv + (size_t)(Rq_ - 128 + row) * NQKV + 1280 + kvh_ * 64 + 8 * ch); } } } while (0)
    bf16x8 qf[2][4];
#define AT_LOADQ(rep_, it_) do { const int kvh_ = (it_) & 3, qb_ = ((it_) >> 2) & 15, b_ = (it_) >> 6, Rq_ = b_ * TSEQ + qb_ * 128, wi_ = wave + 8 * (rep_), ln_ = tid0 & 63; \
        _Pragma("unroll") for (int ks = 0; ks < 4; ++ks) qf[rep_][ks] = *(const bf16x8*)(qkv + (size_t)(Rq_ + 32 * (wi_ & 3) + (ln_ & 31)) * NQKV + (kvh_ * 4 + (wi_ >> 2)) * 64 + 16 * ks + 8 * (ln_ >> 5)); } while (0)
    if (cnt > 0) { AT_LOADKV(first); AT_LOADQ(0, first); AT_LOADQ(1, first); }
    LAS float* sinks_l = (LAS float*)(lds + AT_O + 8 * 32 * AT_ORS);
    if (tid0 < 16) sinks_l[tid0] = P.in[I_SINKS][tid0];
    for (int kk = 0; kk < cnt; ++kk) {
        const int it = first + kk;
        int tid = tid0; asm volatile("" : "+v"(tid));
        const int lane = tid & 63;
        const int kvh = it & 3, qb = (it >> 2) & 15, b = it >> 6;
        const int Rq = b * TSEQ + qb * 128;
        BAR_LDS();
#pragma unroll
        for (int rep = 0; rep < 4; ++rep) {
            const int idx = tid + 512 * rep;
            { const int row = idx >> 3, ch = idx & 7; *(LAS u32x4*)(lds + AT_K + img128(row, ch)) = kraw[rep]; *(LAS u32x4*)(lds + AT_V + at_vst(row, 8 * ch)) = vraw[rep]; }
        }
        const int r = lane & 31, hh = lane >> 5;
        BAR_LDS();
#pragma unroll
        for (int rep = 0; rep < (MODE == 1 ? 0 : 2); ++rep) {
            const int wi = wave + 8 * rep, g = wi >> 2, q0 = 32 * (wi & 3), hq = kvh * 4 + g;
            const float L2E = 1.4426950408889634f;
            const float slope = alibi_slope(hq) * L2E, sink = sinks_l[hq] * L2E;
            const int ktmin = (qb > 0) ? 0 : 4 - (wi & 3);
            f32x16 sc[5];
#pragma unroll
            for (int kt = 0; kt < 5; ++kt) {
                f32x16 a = {0.f, 0.f, 0.f, 0.f, 0.f, 0.f, 0.f, 0.f, 0.f, 0.f, 0.f, 0.f, 0.f, 0.f, 0.f, 0.f};
#pragma unroll
                for (int ks = 0; ks < 4; ++ks) { const bf16x8 kf = *(const LAS bf16x8*)(lds + AT_K + img128(q0 + 32 * kt + r, 2 * ks + hh)); a = MFMA32(kf, qf[rep][ks], a); }
                sc[kt] = a;
            }
            if (kk + 1 < cnt) { AT_LOADQ(rep, it + 1); if (rep == AT_KVREP) AT_LOADKV(it + 1); }
            float m = sink; f32x2 sum2 = {0.f, 0.f};
            if (MODE != 3) {
            const float tl = slope * (float)(4 * hh - 128 - r);
            const int dl = r - 4 * hh;
            const f32x2 C2 = {0.125f * L2E, 0.125f * L2E};
            f32x2 bias2[8];
#pragma unroll
            for (int e2 = 0; e2 < 8; ++e2) { const int rowc = ((2 * e2) & 3) + 8 * ((2 * e2) >> 2); bias2[e2] = (f32x2){tl + slope * (float)rowc, tl + slope * (float)(rowc + 1)}; }
#pragma unroll
            for (int kt = 0; kt < 5; ++kt) {
                float mt = -1e30f;
#pragma unroll
                for (int e2 = 0; e2 < 8; ++e2) { const int e0 = 2 * e2, rowc = (e0 & 3) + 8 * (e0 >> 2);
                    f32x2 sv = (f32x2){sc[kt][e0], sc[kt][e0 + 1]} * C2 + bias2[e2];
                    if (kt == 0) { sv.x = (rowc < dl) ? -1e30f : sv.x; sv.y = (rowc + 1 < dl) ? -1e30f : sv.y; }
                    if (kt == 4) { sv.x = (rowc > dl) ? -1e30f : sv.x; sv.y = (rowc + 1 > dl) ? -1e30f : sv.y; }
                    sc[kt][e0] = sv.x; sc[kt][e0 + 1] = sv.y; mt = max3_(mt, sv.x, sv.y); }
                mt += slope * (float)(32 * kt);
                m = fmaxf(m, (kt >= ktmin) ? mt : -1e30f);
            }
            m = fmaxf(m, __shfl_xor(m, 32));
#pragma unroll
            for (int kt = 0; kt < 5; ++kt) {
                const float ck = (kt >= ktmin) ? slope * (float)(32 * kt) - m : -1e30f;
                const f32x2 ck2 = {ck, ck};
#pragma unroll
                for (int e2 = 0; e2 < 8; ++e2) { f32x2 p = (f32x2){sc[kt][2 * e2], sc[kt][2 * e2 + 1]} + ck2;
                    p.x = __builtin_amdgcn_exp2f(p.x); p.y = __builtin_amdgcn_exp2f(p.y);
                    sc[kt][2 * e2] = p.x; sc[kt][2 * e2 + 1] = p.y; sum2 += p; }
            }
            }
            float sum = sum2.x + sum2.y;
            sum += __shfl_xor(sum, 32);
            const float inv = __builtin_amdgcn_rcpf(sum + __builtin_amdgcn_exp2f(sink - m));
            f32x16 O[2];
#pragma unroll
            for (int dt = 0; dt < 2; ++dt) O[dt] = (f32x16){0.f, 0.f, 0.f, 0.f, 0.f, 0.f, 0.f, 0.f, 0.f, 0.f, 0.f, 0.f, 0.f, 0.f, 0.f, 0.f};
            const LAS unsigned char* vb0 = lds + AT_V + q0 * 128 + hh * 1024 + ((lane >> 2) & 3) * 64 + ((lane >> 4) & 1) * 32 + (lane & 3) * 8;
#pragma unroll
            for (int kt = 0; kt < 5; ++kt) {
#pragma unroll
                for (int s2 = 0; s2 < 2; ++s2) {
                    const bf16x8 pa = pack_acc(sc[kt], s2);
#pragma unroll
                    for (int dt = 0; dt < 2; ++dt) {
                        const LAS unsigned char* vp = vb0 + (32 * kt + 16 * s2) * 128 + dt * 512;
                        const s16x4 lo = __builtin_amdgcn_ds_read_tr16_b64_v4i16((LAS s16x4*)vp), hi = __builtin_amdgcn_ds_read_tr16_b64_v4i16((LAS s16x4*)(vp + 256));
                        const bf16x8 vb = __builtin_bit_cast(bf16x8, (short __attribute__((ext_vector_type(8)))){lo[0], lo[1], lo[2], lo[3], hi[0], hi[1], hi[2], hi[3]});
                        O[dt] = MFMA32(vb, pa, O[dt]);
                    }
                }
            }
            LAS unsigned char* ot = lds + AT_O + wave * (32 * AT_ORS);
#pragma unroll
            for (int dt = 0; dt < 2; ++dt)
#pragma unroll
                for (int g4 = 0; g4 < 4; ++g4) {
                    const u32x2 w = {pk2(O[dt][4 * g4] * inv, O[dt][4 * g4 + 1] * inv), pk2(O[dt][4 * g4 + 2] * inv, O[dt][4 * g4 + 3] * inv)};
                    *(LAS u32x2*)(ot + r * AT_ORS + (32 * dt + 8 * g4 + 4 * hh) * 2) = w;
                }
#pragma unroll
            for (int i = 0; i < 4; ++i) { const int row = 8 * i + (lane >> 3), ch = lane & 7;
                const u32x4 w = *(const LAS u32x4*)(ot + row * AT_ORS + ch * 16);
                if (MODE != 2 || w.x == 0x12345679u) *(u32x4*)(att + (size_t)(Rq + q0 + row) * D + hq * 64 + 8 * ch) = w; }
            asm volatile("" ::: "memory");
        }
        if (qb == 15) {
            for (int idx = tid; idx < 128 * 64; idx += 512) { const int j = idx >> 6, d = idx & 63;
                const bf16_t kv = *(const LAS bf16_t*)(lds + AT_K + img128(128 + j, d >> 3) + (d & 7) * 2);
                const bf16_t vv = *(const LAS bf16_t*)(lds + AT_V + at_vst(128 + j, d));
                P.out[O_PSWAK + (((size_t)b * 128 + j) * 4 + kvh) * 64 + d] = bf2f(kv);
                P.out[O_PSWAV + (((size_t)b * 128 + j) * 4 + kvh) * 64 + d] = bf2f(vv); }
        }
    }
#undef AT_LOADKV
#undef AT_LOADQ
}

DI void attn_sample_item(const Params& P, LAS unsigned char* lds, int s) {
    int tid = threadIdx.x; asm volatile("" : "+v"(tid));
    const int hq = tid >> 5, sub = tid & 31, kvh = hq >> 2, r = MP + s;
    const bf16_t* qkv = (const bf16_t*)(P.ws + WS_BIG);
    bf16_t* att = (bf16_t*)(P.ws + WS_MIX);
    LAS float* qs = (LAS float*)lds;
    LAS float* kn = qs + 1024;
    LAS float* vn = kn + 256;
    LAS float* pp = vn + 256;
    __syncthreads();
    { const unsigned w = *(const unsigned*)(qkv + (size_t)r * NQKV + hq * 64 + 2 * sub); qs[hq * 64 + 2 * sub] = bflo(w); qs[hq * 64 + 2 * sub + 1] = bfhi(w); }
    if (tid < 256) kn[tid] = bf2f(qkv[(size_t)r * NQKV + 1024 + tid]); else vn[tid - 256] = bf2f(qkv[(size_t)r * NQKV + 1280 + (tid - 256)]);
    __syncthreads();
    const float slope = alibi_slope(hq), sink = P.in[I_SINKS][hq];
    const float* ck = P.in[I_CK] + (size_t)s * 128 * 256 + kvh * 64; const float* cv = P.in[I_CV] + (size_t)s * 128 * 256 + kvh * 64;
    float sv[5]; float m = sink;
#pragma unroll
    for (int mm = 0; mm < 4; ++mm) { const int j = sub + 32 * mm; const f32x4* kr = (const f32x4*)(ck + (size_t)j * 256); float acc = 0.f;
#pragma unroll
        for (int c = 0; c < 16; ++c) { const f32x4 kv = kr[c]; const f32x4 qv = *(const LAS f32x4*)(qs + hq * 64 + 4 * c); acc += (kv[0] * qv[0] + kv[1] * qv[1]) + (kv[2] * qv[2] + kv[3] * qv[3]); }
        sv[mm] = acc * 0.125f - slope * (float)(128 - j); m = fmaxf(m, sv[mm]); }
    { float acc = 0.f;
#pragma unroll
        for (int c = 0; c < 64; ++c) acc += kn[kvh * 64 + c] * qs[hq * 64 + c];
        sv[4] = acc * 0.125f; m = fmaxf(m, sv[4]); }
#pragma unroll
    for (int o = 1; o < 32; o <<= 1) m = fmaxf(m, __shfl_xor(m, o));
    float sum = 0.f;
#pragma unroll
    for (int mm = 0; mm < 4; ++mm) { const float p = __expf(sv[mm] - m); pp[hq * 132 + sub + 32 * mm] = p; sum += p; }
#pragma unroll
    for (int o = 1; o < 32; o <<= 1) sum += __shfl_xor(sum, o);
    const float pnew = __expf(sv[4] - m);
    const float inv = 1.0f / (sum + pnew + __expf(sink - m));
    __syncthreads();
    float o0 = pnew * vn[kvh * 64 + 2 * sub], o1 = pnew * vn[kvh * 64 + 2 * sub + 1];
#pragma unroll 32
    for (int j = 0; j < 128; ++j) { const float p = pp[hq * 132 + j]; const f32x2 vv = *(const f32x2*)(cv + (size_t)j * 256 + 2 * sub); o0 += p * vv[0]; o1 += p * vv[1]; }
    *(unsigned*)(att + (size_t)r * D + hq * 64 + 2 * sub) = pk2(o0 * inv, o1 * inv);
    float* ok = P.out + O_SSWAK + (size_t)s * 128 * 256; float* ov = P.out + O_SSWAV + (size_t)s * 128 * 256;
    if (tid < 256) ok[127 * 256 + tid] = kn[tid]; else ov[127 * 256 + (tid - 256)] = vn[tid - 256];
}

template <int DRY>
DI void final_norm(const Params& P, int vcu, int G, int m0) {
    int tid = threadIdx.x; asm volatile("" : "+v"(tid)); const int lane = tid & 63, wave = tid >> 6;
    const float* ss4 = (const float*)(P.ws + WS_SS) + 4 * (size_t)MPAD; const float* w = P.in[I_NFIN];
    const bf16_t* XB = (const bf16_t*)(P.ws + WS_XB);
    f32x4 wv[4];
#pragma unroll
    for (int j = 0; j < 4; ++j) wv[j] = *((const f32x4*)w + 2 * lane + 128 * (j >> 1) + (j & 1));
    for (int m = m0 + vcu * 8 + wave; m < MREAL; m += G * 8) {
        const float rs = rsqrtf(ss4[m] * (1.0f / 1024.0f) + EPS);
        const u32x4 a = *((const u32x4*)(XB + (size_t)m * D) + lane), b = *((const u32x4*)(XB + (size_t)m * D) + 64 + lane);
        f32x4* row = (f32x4*)(P.out + (size_t)m * D);
        const f32x4 o0 = (f32x4){bflo(a.x), bfhi(a.x), bflo(a.y), bfhi(a.y)} * rs * wv[0], o1 = (f32x4){bflo(a.z), bfhi(a.z), bflo(a.w), bfhi(a.w)} * rs * wv[1];
        const f32x4 o2 = (f32x4){bflo(b.x), bfhi(b.x), bflo(b.y), bfhi(b.y)} * rs * wv[2], o3 = (f32x4){bflo(b.z), bfhi(b.z), bflo(b.w), bfhi(b.w)} * rs * wv[3];
        if (!DRY || (o0[0] == 123.4567f && o1[1] == 7.654321f)) { row[2 * lane] = o0; row[2 * lane + 1] = o1; row[128 + 2 * lane] = o2; row[128 + 2 * lane + 1] = o3; }
    }
}
constexpr int N_PHASES = 13;
#ifndef DUP_FULL
#define DUP_FULL 0
#endif
#ifndef TAILRES_DUP
#define TAILRES_DUP 1
#endif
#ifndef FUSE_FINAL
#define FUSE_FINAL 1
#endif
#ifndef P8_PROBE
#define P8_PROBE 0
#endif
#ifndef TAIL_DUP
#define TAIL_DUP 1
#endif
#ifndef P12_DUP
#define P12_DUP 0
#endif
#ifndef PREP_PROBE_MODE
#define PREP_PROBE_MODE 0
#endif
__global__ void __launch_bounds__(512, 2) hybrid_fwd(Params P) {
    extern __shared__ __attribute__((aligned(16))) unsigned char lds_raw[];
    LAS unsigned char* lds = (LAS unsigned char*)lds_raw;
    const int tid = threadIdx.x, G = gridDim.x, bx = blockIdx.x;
    const int vcu = (G % 8 == 0) ? (bx % 8) * (G / 8) + bx / 8 : bx;
    volatile LAS unsigned* MISC = (volatile LAS unsigned*)(lds + LDS_MISC);
    if (tid < 64) MISC[tid] = 0u;
    __syncthreads();
    XcdBarrier bar = xcd_barrier_post((unsigned*)(P.ws + WS_CTL), MISC + 8);
    const int lo = P.ph_lo, hi = P.ph_hi;
#ifndef PH_MASK
#define PH_MASK 0x1fff
#endif
#define IN(k) ((((PH_MASK) >> (k)) & 1) && lo <= (k) && (k) < hi)
#ifndef DUP_BAR
#define DUP_BAR 1
#endif
#define SEAM(k) do { if (IN(k) && IN((k) + 1)) { for (int b_ = 0; b_ < DUP_BAR; ++b_) xcd_barrier(bar); } } while (0)
#ifndef DUP_MASK
#define DUP_MASK 0
#endif
#define NREP(k) ((((DUP_MASK) >> (k)) & 1) ? 2 : 1)
    bf16_t* Wb = (bf16_t*)(P.ws + WS_W);
    bf16_t* XB = (bf16_t*)(P.ws + WS_XB); bf16_t* BIG = (bf16_t*)(P.ws + WS_BIG); bf16_t* MIX = (bf16_t*)(P.ws + WS_MIX);
    float* SS = (float*)(P.ws + WS_SS);
    bf16_t* XB0 = (bf16_t*)P.out;

    if (IN(0)) for (int rep_ = 0; rep_ < NREP(0); ++rep_) { p0_prologue(P, lds, vcu, G); __syncthreads(); }
    SEAM(0);
    if (IN(1)) for (int rep_ = 0; rep_ < NREP(1); ++rep_) {
        pg8::Gemm g{XB0, Wb + W_IN, MP, NIN, D}; pg8::StaticOrder S; S.init(MP, NIN, G, bx);
        pg8::EpiScaleBf16 E{BIG, NIN, SS, DUP_FULL ? 0 : rep_};
        pg8::gemm_phase(lds, g, S, E);
        pg8::TailArgs t{XB0, Wb + W_IN, D, NIN, BIG, NIN, SS, nullptr, nullptr, nullptr, -1, {nullptr, nullptr}, {nullptr, nullptr}};
        if (rep_ == 0) for (int tr_ = 0; tr_ < TAIL_DUP; ++tr_) pg8::gemm_tail<pg8::TAIL_SCALE>(t, G);
    }
    SEAM(1);
    if (IN(2)) for (int rep_ = 0; rep_ < NREP(2); ++rep_) { if (rep_ == 0) gdn_prep_phase<0>(P, lds, bx, G); else gdn_prep_phase<PREP_PROBE_MODE>(P, lds, bx, G); }
    SEAM(2);
    if (IN(3)) for (int rep_ = 0; rep_ < NREP(3); ++rep_) {
        for (int u = bx; u < 256; u += G) {
#ifndef P3_PART
#define P3_PART 7
#endif
#ifndef PREP_PROBE_MODE
#define PREP_PROBE_MODE 0
#endif
#ifndef DUP_P3
#define DUP_P3 0
#endif
#ifndef SCAN_PROBE_MODE
#define SCAN_PROBE_MODE 0
#endif
#ifndef P3_SKIP
#define P3_SKIP 0
#endif
            if (u < 64) { if (!(P3_SKIP & 1)) for (int r2 = 0; r2 < ((DUP_P3 & 1) ? 2 : 1); ++r2) { if (r2 == 0) gdn_scan_block<0>(P, lds, u); else gdn_scan_block<SCAN_PROBE_MODE>(P, lds, u); __syncthreads(); } }
            else if (u < 192) { if (!(P3_SKIP & 2)) for (int r2 = 0; r2 < ((DUP_P3 & 2) ? 2 : 1); ++r2) { lru_block(P, lds, u - 64); __syncthreads(); } }
            else { if (!(P3_SKIP & 4)) for (int r2 = 0; r2 < ((DUP_P3 & 4) ? 2 : 1); ++r2) { sample_ab_block(P, lds, u - 192); __syncthreads(); } }
            __syncthreads();
        }
    }
    SEAM(3);
    if (IN(4)) for (int rep_ = 0; rep_ < NREP(4); ++rep_) {
        pg8::Gemm g{MIX, Wb + W_OUTAB, MP, D, D}; pg8::StaticOrder S; S.init(MP, D, G, bx);
        pg8::EpiResidual E{XB0, XB, SS + 1 * (size_t)MPAD, rep_, lds};
        pg8::gemm_phase(lds, g, S, E);
        pg8::TailArgs t{MIX, Wb + W_OUTAB, D, D, nullptr, 0, nullptr, XB0, XB, SS + 1 * (size_t)MPAD, 0, {(const f32x4*)P.in[I_CK], (const f32x4*)P.in[I_CV]}, {(f32x4*)(P.out + O_SSWAK), (f32x4*)(P.out + O_SSWAV)}};
        if (rep_ == 0) pg8::gemm_tail_res(t, G, lds);
    }
    SEAM(4);
    if (IN(5)) for (int rep_ = 0; rep_ < NREP(5); ++rep_) {
        pg8::Gemm g{XB, Wb + W_GU0, MP, NGU, D}; pg8::StaticOrder S; S.init(MP, NGU, G, bx);
        pg8::EpiSwiglu E{BIG, SS + 1 * (size_t)MPAD};
        pg8::gemm_phase(lds, g, S, E);
        pg8::TailArgs t{XB, Wb + W_GU0, D, FF, BIG, FF, SS + 1 * (size_t)MPAD, nullptr, nullptr, nullptr, -1, {nullptr, nullptr}, {nullptr, nullptr}};
        for (int tr_ = 0; tr_ < TAIL_DUP; ++tr_) pg8::gemm_tail<pg8::TAIL_SWIGLU>(t, G);
    }
    SEAM(5);
    if (IN(6)) for (int rep_ = 0; rep_ < NREP(6); ++rep_) {
        pg8::Gemm g{BIG, Wb + W_DN0, MP, D, FF}; pg8::StaticOrder S; S.init(MP, D, G, bx);
        pg8::EpiResidual E{XB, XB, SS + 2 * (size_t)MPAD, rep_, lds};
        pg8::gemm_phase(lds, g, S, E);
        pg8::TailArgs t{BIG, Wb + W_DN0, FF, D, nullptr, 0, nullptr, XB, XB, SS + 2 * (size_t)MPAD, 1, {(const f32x4*)P.in[I_CK], (const f32x4*)P.in[I_CV]}, {(f32x4*)(P.out + O_SSWAK), (f32x4*)(P.out + O_SSWAV)}};
        if (rep_ == 0) pg8::gemm_tail_res(t, G, lds);
    }
    SEAM(6);
    if (IN(7)) {
        pg8::Gemm g{XB, Wb + W_QKV, MP, NQKV, D}; pg8::StaticOrder S; S.init(MP, NQKV, G, bx);
        pg8::EpiScaleBf16 E{BIG, NQKV, SS + 2 * (size_t)MPAD, 0};
        pg8::gemm_phase(lds, g, S, E);
        pg8::TailArgs t{XB, Wb + W_QKV, D, NQKV, BIG, NQKV, SS + 2 * (size_t)MPAD, nullptr, nullptr, nullptr, -1, {nullptr, nullptr}, {nullptr, nullptr}};
        for (int tr_ = 0; tr_ < TAIL_DUP; ++tr_) pg8::gemm_tail<pg8::TAIL_SCALE>(t, G);
    }
    SEAM(7);
    if (IN(8)) for (int rep_ = 0; rep_ < NREP(8); ++rep_) {
#ifndef P8_PART
#define P8_PART 3
#endif
        if (G == 256) {
#ifndef P8_SPLIT
#define P8_SPLIT 3
#endif
            if (rep_ == 0) {
            if (bx < NS) { attn_sample_item(P, lds, bx); attn_prompt_run<0>(P, lds, P8_SPLIT * bx, P8_SPLIT); }
            else { attn_prompt_run<0>(P, lds, 128 * P8_SPLIT + (8 - P8_SPLIT) * (bx - NS), 8 - P8_SPLIT); }
            } else {
            if (bx < NS) { if (!(P8_PROBE & 16)) attn_sample_item(P, lds, bx); attn_prompt_run<(P8_PROBE & 15)>(P, lds, P8_SPLIT * bx, P8_SPLIT); }
            else { attn_prompt_run<(P8_PROBE & 15)>(P, lds, 128 * P8_SPLIT + (8 - P8_SPLIT) * (bx - NS), 8 - P8_SPLIT); }
            }
        } else {
            for (int s = bx; s < NS; s += G) attn_sample_item(P, lds, s);
            for (int it = bx; it < 1024; it += G) attn_prompt_run<0>(P, lds, it, 1);
        }
    }
    SEAM(8);
    if (IN(9)) for (int rep_ = 0; rep_ < NREP(9); ++rep_) {
        if (FUSE_FINAL) { unsigned long long* sl_ = (unsigned long long*)(P.ws + WS_BA); for (int i = bx * 512 + tid; i < 128 * 1024; i += G * 512) sl_[i] = 0ull; }
        pg8::Gemm g{MIX, Wb + W_OUTC, MP, D, D}; pg8::StaticOrder S; S.init(MP, D, G, bx);
        pg8::EpiResidual E{XB, XB, SS + 3 * (size_t)MPAD, rep_, lds};
        pg8::gemm_phase(lds, g, S, E);
        pg8::TailArgs t{MIX, Wb + W_OUTC, D, D, nullptr, 0, nullptr, XB, XB, SS + 3 * (size_t)MPAD, 2, {(const f32x4*)P.in[I_CK], (const f32x4*)P.in[I_CV]}, {(f32x4*)(P.out + O_SSWAK), (f32x4*)(P.out + O_SSWAV)}};
        if (rep_ == 0) pg8::gemm_tail_res(t, G, lds);
    }
    SEAM(9);
    if (IN(10)) {
        pg8::Gemm g{XB, Wb + W_GU1, MP, NGU, D}; pg8::StaticOrder S; S.init(MP, NGU, G, bx);
        pg8::EpiSwiglu E{BIG, SS + 3 * (size_t)MPAD};
        pg8::gemm_phase(lds, g, S, E);
        pg8::TailArgs t{XB, Wb + W_GU1, D, FF, BIG, FF, SS + 3 * (size_t)MPAD, nullptr, nullptr, nullptr, -1, {nullptr, nullptr}, {nullptr, nullptr}};
        for (int tr_ = 0; tr_ < TAIL_DUP; ++tr_) pg8::gemm_tail<pg8::TAIL_SWIGLU>(t, G);
    }
    SEAM(10);
    if (IN(11)) {
        pg8::Gemm g{BIG, Wb + W_DN1, MP, D, FF}; pg8::StaticOrder S; S.init(MP, D, G, bx);
        if (FUSE_FINAL && G == 256) { pg8::EpiResidualFinal E{XB, P.out, P.in[I_NFIN], (unsigned long long*)(P.ws + WS_BA), lds}; pg8::gemm_phase(lds, g, S, E); }
        else { pg8::EpiResidual E{XB, XB, SS + 4 * (size_t)MPAD, 0, lds}; pg8::gemm_phase(lds, g, S, E); }
        pg8::TailArgs t{BIG, Wb + W_DN1, FF, D, nullptr, 0, nullptr, XB, XB, SS + 4 * (size_t)MPAD, 3, {(const f32x4*)P.in[I_CK], (const f32x4*)P.in[I_CV]}, {(f32x4*)(P.out + O_SSWAK), (f32x4*)(P.out + O_SSWAV)}};
        pg8::gemm_tail_res(t, G, lds);
    }
    SEAM(11);
    if (IN(12)) final_norm<0>(P, vcu, G, (FUSE_FINAL && G == 256) ? MP : 0);
#undef IN
#undef SEAM
}

#ifndef MK_N_LAUNCHES
#define MK_N_LAUNCHES 1
#endif
extern "C" void kernel_launch(void* const* d_in, const int* in_sizes, int n_in, void* d_out, int out_size, void* d_ws, size_t ws_size, hipStream_t stream) {
    static int grid = 0;
    if (grid == 0) {
        if (n_in != 29 || out_size != (int)O_END || ws_size < WS_END) { fprintf(stderr, "kernel_launch: unexpected shapes: n_in %d out %d ws %zu (need %zu)\n", n_in, out_size, ws_size, (size_t)WS_END); grid = -1; return; }
        int dev = 0, cus = 0;
        if (hipGetDevice(&dev) != hipSuccess || hipDeviceGetAttribute(&cus, hipDeviceAttributeMultiprocessorCount, dev) != hipSuccess) { grid = -1; return; }
        if (hipFuncSetAttribute((const void*)hybrid_fwd, hipFuncAttributeMaxDynamicSharedMemorySize, LDS_BYTES) != hipSuccess) { fprintf(stderr, "kernel_launch: hipFuncSetAttribute failed\n"); grid = -1; return; }
        int per_cu = 0;
        if (hipOccupancyMaxActiveBlocksPerMultiprocessor(&per_cu, (const void*)hybrid_fwd, 512, LDS_BYTES) != hipSuccess || per_cu < 1) fprintf(stderr, "kernel_launch: occupancy query says %d blocks per CU\n", per_cu);
        (void)hipGetLastError();
        grid = cus;
    }
    if (grid < 0) return;
    Params p{};
    for (int i = 0; i < 29; ++i) p.in[i] = (const float*)d_in[i];
    p.out = (float*)d_out; p.ws = (unsigned char*)d_ws;
    if (MK_N_LAUNCHES == 1) {
        (void)hipMemsetAsync((char*)d_ws + WS_CTL, 0, CTL_BYTES, stream);
        p.ph_lo = 0; p.ph_hi = N_PHASES;
        hipLaunchKernelGGL(hybrid_fwd, dim3(grid), dim3(512), LDS_BYTES, stream, p);
    } else {
        (void)hipMemsetAsync((char*)d_ws + WS_CTL, 0, CTL_BYTES, stream);
        for (int ph = 0; ph < N_PHASES; ++ph) { p.ph_lo = ph; p.ph_hi = ph + 1; hipLaunchKernelGGL(hybrid_fwd, dim3(grid), dim3(512), LDS_BYTES, stream, p); }
    }
    const hipError_t le = hipPeekAtLastError();
    if (le != hipSuccess) fprintf(stderr, "kernel_launch: launch failed: %s\n", hipGetErrorName(le));
}
```

```cpp
#include <hip/hip_runtime.h>
#include <cstdio>
#include <cstdint>

#define DI __device__ __forceinline__
#define LAS __attribute__((address_space(3)))
typedef unsigned short bf16_t;
typedef short bf16x8 __attribute__((ext_vector_type(8)));
typedef short bf16x4 __attribute__((ext_vector_type(4)));
typedef float f32x2 __attribute__((ext_vector_type(2)));
typedef float f32x4 __attribute__((ext_vector_type(4)));
typedef float f32x16 __attribute__((ext_vector_type(16)));
typedef unsigned u32x2 __attribute__((ext_vector_type(2)));
typedef unsigned u32x4 __attribute__((ext_vector_type(4)));
typedef __bf16 bf16v2 __attribute__((ext_vector_type(2)));

DI unsigned pk2(float a, float b) { bf16v2 v = {(__bf16)a, (__bf16)b}; return __builtin_bit_cast(unsigned, v); }
DI bf16_t f2bf(float a) { __bf16 v = (__bf16)a; return __builtin_bit_cast(bf16_t, v); }
DI float bf2f(unsigned h) { return __uint_as_float(h << 16); }
DI float bflo(unsigned w) { return __uint_as_float(w << 16); }
DI float bfhi(unsigned w) { return __uint_as_float(w & 0xffff0000u); }
DI float wave_sum(float v) {
#pragma unroll
    for (int o = 1; o < 64; o <<= 1) v += __shfl_xor(v, o);
    return v;
}
DI float sigmoidf_(float x) { return __builtin_amdgcn_rcpf(1.f + __expf(-x)); }
DI float siluf_(float x) { return x * __builtin_amdgcn_rcpf(1.f + __expf(-x)); }
DI float softplusf_(float x) { return fmaxf(x, 0.f) + log1pf(__expf(-fabsf(x))); }
DI float gelu_tanh(float x) { const float u = 0.7978845608028654f * (x + 0.044715f * x * x * x); return x * __builtin_amdgcn_rcpf(1.f + __expf(-2.0f * u)); }
#define BAR_LDS() do { asm volatile("s_waitcnt lgkmcnt(0)" ::: "memory"); __builtin_amdgcn_s_barrier(); asm volatile("" ::: "memory"); } while (0)

constexpr int D = 1024, TSEQ = 2048, NBATCH = 16, MP = NBATCH * TSEQ, NS = 128, MREAL = MP + NS, MPAD = 33024;
constexpr int NIN = 3072, FF = 2816, NGU = 2 * FF, NQKV = 1536;
constexpr float EPS = 1e-6f;
constexpr int NCHUNK = 32;
constexpr int NCHUNKS = NBATCH * 4 * NCHUNK;

constexpr size_t O_Y = 0;
constexpr size_t O_PGDN = (size_t)MREAL * D;
constexpr size_t O_PGDNCONV = O_PGDN + (size_t)16 * 4 * 128 * 128;
constexpr size_t O_PLRU = O_PGDNCONV + (size_t)16 * 3 * 1536;
constexpr size_t O_PLRUCONV = O_PLRU + (size_t)16 * 512;
constexpr size_t O_PSWAK = O_PLRUCONV + (size_t)16 * 3 * 512;
constexpr size_t O_PSWAV = O_PSWAK + (size_t)16 * 128 * 256;
constexpr size_t O_SGDN = O_PSWAV + (size_t)16 * 128 * 256;
constexpr size_t O_SGDNCONV = O_SGDN + (size_t)128 * 4 * 128 * 128;
constexpr size_t O_SLRU = O_SGDNCONV + (size_t)128 * 3 * 1536;
constexpr size_t O_SLRUCONV = O_SLRU + (size_t)128 * 512;
constexpr size_t O_SSWAK = O_SLRUCONV + (size_t)128 * 3 * 512;
constexpr size_t O_SSWAV = O_SSWAK + (size_t)128 * 128 * 256;
constexpr size_t O_END = O_SSWAV + (size_t)128 * 128 * 256;
static_assert(O_END == 53518336, "output size");

constexpr size_t MiB = 1u << 20;
constexpr size_t WS_CTL = 0, CTL_BYTES = 65536;
constexpr size_t WS_SS = 1 * MiB;
constexpr size_t SS_STRIDE = (size_t)MPAD * 4;
constexpr size_t WS_BA = 2 * MiB;
constexpr size_t WS_GT = WS_BA + (size_t)MPAD * 8 * 4;
constexpr size_t WS_W = 4 * MiB;
constexpr size_t W_IN = 0, W_OUTAB = W_IN + (size_t)NIN * D, W_GU0 = W_OUTAB + (size_t)D * D, W_GU1 = W_GU0 + (size_t)NGU * D,
                 W_DN0 = W_GU1 + (size_t)NGU * D, W_DN1 = W_DN0 + (size_t)D * FF, W_QKV = W_DN1 + (size_t)D * FF, W_OUTC = W_QKV + (size_t)NQKV * D,
                 W_END = W_OUTC + (size_t)D * D;
static_assert(W_END * 2 <= 50 * MiB, "weights");
constexpr size_t WS_BIG = 54 * MiB;
constexpr size_t BIG_BYTES = (size_t)MPAD * NIN * 2;
constexpr size_t WS_MIX = 250 * MiB;
constexpr size_t WS_XB = 316 * MiB;
constexpr size_t WS_GDNI = WS_XB;
constexpr size_t GDNI_STG = 57344;
constexpr size_t WS_GDNWV = WS_GDNI + (size_t)NCHUNKS * GDNI_STG;
constexpr size_t WS_ZS = WS_GDNWV + (size_t)NCHUNKS * 16384;
constexpr size_t WS_END = WS_ZS + (size_t)NCHUNKS * 16384;
static_assert(WS_BIG + BIG_BYTES <= WS_MIX && WS_MIX + (size_t)MPAD * D * 2 <= WS_XB && WS_END <= 492 * MiB, "ws map");

constexpr int LDS_MISC = 160 * 1024 - 256;
constexpr int LDS_BYTES = 160 * 1024;

#define XB_TMO      128
#define XB_XCNT(j)  (256  + 64 * (j))
#define XB_XSUB(j)  (1280 + 64 * (j))
#define XB_XGEN(j)  (2304 + 64 * (j))
#define XB_TOP      3328
#define XB_TOPGEN   3392
#define XCD_BAR_WORDS 3456
#define XB_SPIN_CAP (1u << 20)
DI unsigned xb_ld(unsigned* p)              { return __hip_atomic_load(p, __ATOMIC_RELAXED, __HIP_MEMORY_SCOPE_AGENT); }
DI unsigned xb_add(unsigned* p, unsigned v) { return __hip_atomic_fetch_add(p, v, __ATOMIC_RELAXED, __HIP_MEMORY_SCOPE_AGENT); }
DI unsigned xb_xcc_id() { return (unsigned)__builtin_amdgcn_s_getreg((3 << 11) | 20) & 0xFu; }
#define XB_SPIN(cond, bar) do { unsigned _sp = 0; while (cond) { __builtin_amdgcn_s_sleep(1); \
    if ((++_sp & 255u) == 0u) { if (xb_ld(&(bar)[XB_TMO])) break; if (_sp > XB_SPIN_CAP) { atomicAdd(&(bar)[XB_TMO], 1u); break; } } } } while (0)
struct XcdBarrier { unsigned* bar; unsigned x; volatile LAS unsigned* st; };
DI XcdBarrier xcd_barrier_post(unsigned* bar, volatile LAS unsigned* st) {
    XcdBarrier b; b.bar = bar; b.x = xb_xcc_id(); b.st = st;
    if (threadIdx.x == 0) (void)xb_add(&bar[XB_XCNT(b.x)], 1u);
    return b;
}
DI void xcd_barrier_complete(unsigned* bar, unsigned x, unsigned& nloc, unsigned& nx) {
    const unsigned G = gridDim.x;
    unsigned sum, cnt, mine, sp = 0u;
    for (;;) {
        sum = 0u; cnt = 0u; mine = 0u;
#pragma unroll
        for (unsigned j = 0; j < 16; ++j) { const unsigned c = xb_ld(&bar[XB_XCNT(j)]); sum += c; cnt += (c > 0u) ? 1u : 0u; mine = (j == x) ? c : mine; }
        if (sum == G) break;
        __builtin_amdgcn_s_sleep(1);
        if ((++sp & 255u) == 0u) { if (xb_ld(&bar[XB_TMO])) break; if (sp > XB_SPIN_CAP) { atomicAdd(&bar[XB_TMO], 1u); break; } }
    }
    nloc = mine > 0u ? mine : 1u; nx = cnt > 0u ? cnt : 1u;
}
DI void xcd_barrier(const XcdBarrier& b) {
    asm volatile("s_waitcnt vmcnt(0)" ::: "memory");
    __syncthreads();
    if (threadIdx.x == 0) {
        unsigned* bar = b.bar;
        __builtin_amdgcn_s_waitcnt(0);
        unsigned nloc = b.st[0], nx = b.st[1];
        if (nloc == 0u) { xcd_barrier_complete(bar, b.x, nloc, nx); b.st[0] = nloc; b.st[1] = nx; }
        const unsigned old = xb_add(&bar[XB_XSUB(b.x)], 1u);
        const unsigned gen = old / nloc;
        if (old + 1u == (gen + 1u) * nloc) {
            __builtin_amdgcn_fence(__ATOMIC_RELEASE, "agent");
            asm volatile("s_waitcnt vmcnt(0)" ::: "memory");
            const unsigned og = xb_add(&bar[XB_TOP], 1u);
            const unsigned tgt = (og / nx + 1u) * nx;
            if (og + 1u != tgt) XB_SPIN(xb_ld(&bar[XB_TOP]) < tgt, bar);
            __builtin_amdgcn_fence(__ATOMIC_ACQUIRE, "agent");
            xb_add(&bar[XB_XGEN(b.x)], 1u);
            asm volatile("s_waitcnt vmcnt(0)" ::: "memory");
        } else {
            XB_SPIN(xb_ld(&bar[XB_XGEN(b.x)]) == gen, bar);
            __builtin_amdgcn_fence(__ATOMIC_ACQUIRE, "agent");
            asm volatile("s_waitcnt vmcnt(0)" ::: "memory");
        }
    }
    __syncthreads();
}

struct Params { const float* in[29]; float* out; unsigned char* ws; int ph_lo, ph_hi; };
static_assert(sizeof(Params) == 29 * 8 + 16 + 8, "Params has no padding");
enum { I_XP = 0, I_XS, I_SGDN, I_SGDNCONV, I_SLRU, I_SLRUCONV, I_CK, I_CV, I_NMIX, I_NFFN, I_NFIN, I_WIN, I_CONVG, I_ALOG, I_DTB, I_GNW,
       I_CONVL, I_CONVLB, I_LWA, I_LBA, I_LWX, I_LBX, I_LLAM, I_WOUTAB, I_WQKV, I_WOUTC, I_SINKS, I_WGU, I_WDN };
#ifndef PG8_NT
#define PG8_NT 0
#endif
#if PG8_NT == 1
#define PG8_ST(p_, v_) __builtin_nontemporal_store((v_), (p_))
#else
#define PG8_ST(p_, v_) (*(p_) = (v_))
#endif
#if PG8_NT >= 1
#define PG8_STH(p_, v_) __builtin_nontemporal_store((v_), (p_))
#else
#define PG8_STH(p_, v_) (*(p_) = (v_))
#endif
#ifndef PG8_WGN
#define PG8_WGN 4
#endif
#ifndef PG8_BSTAT
#define PG8_BSTAT 1
#endif
#ifndef PG8_SP2
#define PG8_SP2 1
#endif
#ifndef PG8_ALIGN_EPI
#define PG8_ALIGN_EPI 1
#endif
namespace pg8 {
constexpr int BM = 256, BK = 64, HALF = 128, HTB = HALF * BK * 2, STAGE_BYTES = 8 * HTB, NXCD = 8, WGM = 8;
DI int lds_byte(int r, int c) { const int st = (r >> 4) * 2 + (c >> 5), rr = r & 15, cc = c & 31, ob = rr * 64 + cc * 2; return st * 1024 + (ob ^ (((ob >> 9) & 1) << 5)); }
DI void stage_rc(int b, int& R, int& C) { const int st = b / 1024, sb = b % 1024, swz = sb ^ (((sb >> 9) & 1) << 5); R = (st >> 1) * 16 + swz / 64; C = (st & 1) * 32 + (swz % 64) / 2; }
DI int perm32(int rho) { const int n = rho >> 4, i = rho & 15; return 8 * (i >> 2) + 4 * n + (i & 3); }
struct Unit { int pm, pn; };
struct Gemm { const bf16_t* A; const bf16_t* Bt; int M, N, K; };
struct StaticOrder {
    int nM, nN, nwg, G, c;
    DI void init(int M, int N, int G_, int c_) { nM = M / BM; nN = N / BM; nwg = nM * nN; G = G_; c = c_; }
    DI bool next(int i, Unit& u) const {
        const long L = (long)i * G + c; if (L >= nwg) return false;
        int wgid = (int)L; { const int q = nwg / NXCD, r = nwg % NXCD, xcd = wgid % NXCD, off = wgid / NXCD; wgid = (xcd < r ? xcd * (q + 1) : r * (q + 1) + (xcd - r) * q) + off; }
#if PG8_BSTAT
        const int nig = PG8_WGN * nM, gid = wgid / nig, fn = gid * PG8_WGN, gsz = (nN - fn) < PG8_WGN ? (nN - fn) : PG8_WGN;
        u.pn = fn + ((wgid % nig) % gsz); u.pm = (wgid % nig) / gsz; return true;
#else
        const int nig = WGM * nN, gid = wgid / nig, fm = gid * WGM, gsz = (nM - fm) < WGM ? (nM - fm) : WGM;
        u.pm = fm + ((wgid % nig) % gsz); u.pn = (wgid % nig) / gsz; return true;
#endif
    }
};

struct EpiScaleBf16 {
    static constexpr bool PERM = true;
    bf16_t* O; int ldc; const float* ss; int dry;
    DI void prefetch(float (&pre)[8], const Unit& u, int wr, int fr) const {
#pragma unroll
        for (int k = 0; k < 8; ++k) pre[k] = ss[u.pm * BM + wr * 64 + fr + (k >> 2) * HALF + (k & 3) * 16];
    }
    DI void operator()(const f32x4 (&acc)[2][2][4][2], const Unit& u, int wr, int wc, int fr, int fq, const float (&pre)[8]) const {
        const int row0 = u.pm * BM + wr * 64 + fr, col0 = u.pn * BM + wc * 32 + 8 * fq;
#pragma unroll
        for (int ai = 0; ai < 2; ++ai)
#pragma unroll
            for (int m = 0; m < 4; ++m) {
                const int r = row0 + ai * HALF + m * 16;
                const float rs = __builtin_amdgcn_rsqf(pre[ai * 4 + m] * (1.0f / 1024.0f) + EPS);
                bf16_t* rowp = O + (size_t)r * ldc + col0;
#pragma unroll
                for (int bj = 0; bj < 2; ++bj) {
                    const f32x4 v0 = acc[ai][bj][m][0] * rs, v1 = acc[ai][bj][m][1] * rs;
                    u32x4 w; w.x = pk2(v0[0], v0[1]); w.y = pk2(v0[2], v0[3]); w.z = pk2(v1[0], v1[1]); w.w = pk2(v1[2], v1[3]);
                    if (!dry) PG8_ST((u32x4*)(rowp + bj * HALF), w); else if (w.x == 0x12345679u && w.y == 0x2468ace1u) *(u32x4*)(rowp + bj * HALF) = w;
                }
            }
    }
};
struct EpiSwiglu {
    static constexpr bool PERM = true;
    bf16_t* H; const float* ss;
    DI void prefetch(float (&pre)[8], const Unit& u, int wr, int fr) const {
#pragma unroll
        for (int k = 0; k < 8; ++k) pre[k] = ss[u.pm * BM + wr * 64 + fr + (k >> 2) * HALF + (k & 3) * 16];
    }
    DI void operator()(const f32x4 (&acc)[2][2][4][2], const Unit& u, int wr, int wc, int fr, int fq, const float (&pre)[8]) const {
        const int row0 = u.pm * BM + wr * 64 + fr, col0 = u.pn * HALF + wc * 32 + 8 * fq;
#pragma unroll
        for (int ai = 0; ai < 2; ++ai)
#pragma unroll
            for (int m = 0; m < 4; ++m) {
                const int r = row0 + ai * HALF + m * 16;
                const float rs = __builtin_amdgcn_rsqf(pre[ai * 4 + m] * (1.0f / 1024.0f) + EPS), rs2 = rs * rs, rsl = -1.4426950408889634f * rs;
                float hv[8];
#pragma unroll
                for (int n = 0; n < 2; ++n)
#pragma unroll
                    for (int j = 0; j < 4; ++j) { const float a0 = acc[ai][0][m][n][j];
                        hv[4 * n + j] = (a0 * acc[ai][1][m][n][j]) * rs2 * __builtin_amdgcn_rcpf(1.f + __builtin_amdgcn_exp2f(a0 * rsl)); }
                u32x4 w; w.x = pk2(hv[0], hv[1]); w.y = pk2(hv[2], hv[3]); w.z = pk2(hv[4], hv[5]); w.w = pk2(hv[6], hv[7]);
                PG8_STH((u32x4*)(H + (size_t)r * FF + col0), w);
            }
    }
};
struct EpiResidual {
    static constexpr bool PERM = true;
    const bf16_t* base; bf16_t* XB; float* ss; int dry; LAS unsigned char* lds;
    DI void prefetch(float (&pre)[8], const Unit&, int, int) const {
#pragma unroll
        for (int k = 0; k < 8; ++k) pre[k] = 0.f;
    }
    DI void operator()(const f32x4 (&acc)[2][2][4][2], const Unit& u, int wr, int wc, int fr, int fq, const float (&)[8]) const {
        const int col0 = u.pn * BM + wc * 32 + 8 * fq;
        float qv[8];
#pragma unroll
        for (int ai = 0; ai < 2; ++ai) {
            u32x4 bv[4][2];
#pragma unroll
            for (int m = 0; m < 4; ++m) { const bf16_t* bp = base + (size_t)(u.pm * BM + ai * HALF + wr * 64 + m * 16 + fr) * D + col0;
#pragma unroll
                for (int bj = 0; bj < 2; ++bj) bv[m][bj] = *(const u32x4*)(bp + bj * HALF); }
#pragma unroll
            for (int m = 0; m < 4; ++m) {
                const int r = u.pm * BM + ai * HALF + wr * 64 + m * 16 + fr;
                float q = 0.f;
#pragma unroll
                for (int bj = 0; bj < 2; ++bj) {
                    const u32x4 b4 = bv[m][bj];
                    const f32x4 o0 = (f32x4){bflo(b4.x), bfhi(b4.x), bflo(b4.y), bfhi(b4.y)} + acc[ai][bj][m][0];
                    const f32x4 o1 = (f32x4){bflo(b4.z), bfhi(b4.z), bflo(b4.w), bfhi(b4.w)} + acc[ai][bj][m][1];
                    u32x4 w; w.x = pk2(o0[0], o0[1]); w.y = pk2(o0[2], o0[3]); w.z = pk2(o1[0], o1[1]); w.w = pk2(o1[2], o1[3]);
                    if (dry != 1) PG8_ST((u32x4*)(XB + (size_t)r * D + col0 + bj * HALF), w);
                    q += ((o0[0] * o0[0] + o0[1] * o0[1]) + (o0[2] * o0[2] + o0[3] * o0[3])) + ((o1[0] * o1[0] + o1[1] * o1[1]) + (o1[2] * o1[2] + o1[3] * o1[3]));
                }
                qv[ai * 4 + m] = q;
            }
            asm volatile("" ::: "memory");
        }
#pragma unroll
        for (int k = 0; k < 8; ++k) qv[k] += __shfl_xor(qv[k], 16);
#pragma unroll
        for (int k = 0; k < 8; ++k) qv[k] += __shfl_xor(qv[k], 32);
        LAS float* part = (LAS float*)(lds + STAGE_BYTES);
        if (fq == 0) {
#pragma unroll
            for (int k = 0; k < 8; ++k) part[wc * 256 + (k >> 2) * HALF + wr * 64 + (k & 3) * 16 + fr] = qv[k];
        }
        asm volatile("s_waitcnt lgkmcnt(0)" ::: "memory");
        __builtin_amdgcn_s_barrier();
        if (wr == 0 && dry != 1) { const int row = wc * 64 + fq * 16 + fr;
            atomicAdd(ss + u.pm * BM + row, (part[row] + part[256 + row]) + (part[512 + row] + part[768 + row])); }
    }
};

struct EpiResidualFinal {
    static constexpr bool PERM = true;
    const bf16_t* base; float* Y; const float* w; unsigned long long* slots; LAS unsigned char* lds;
    DI void prefetch(float (&pre)[8], const Unit&, int, int) const {
#pragma unroll
        for (int k = 0; k < 8; ++k) pre[k] = 0.f;
    }
    DI void operator()(f32x4 (&acc)[2][2][4][2], const Unit& u, int wr, int wc, int fr, int fq, const float (&)[8]) const {
        const int col0 = u.pn * BM + wc * 32 + 8 * fq;
        float qv[8];
#pragma unroll
        for (int ai = 0; ai < 2; ++ai) {
            u32x4 bv[4][2];
#pragma unroll
            for (int m = 0; m < 4; ++m) { const bf16_t* bp = base + (size_t)(u.pm * BM + ai * HALF + wr * 64 + m * 16 + fr) * D + col0;
#pragma unroll
                for (int bj = 0; bj < 2; ++bj) bv[m][bj] = *(const u32x4*)(bp + bj * HALF); }
#pragma unroll
            for (int m = 0; m < 4; ++m) {
                float q = 0.f;
#pragma unroll
                for (int bj = 0; bj < 2; ++bj) {
                    const u32x4 b4 = bv[m][bj];
                    const f32x4 o0 = (f32x4){bflo(b4.x), bfhi(b4.x), bflo(b4.y), bfhi(b4.y)} + acc[ai][bj][m][0];
                    const f32x4 o1 = (f32x4){bflo(b4.z), bfhi(b4.z), bflo(b4.w), bfhi(b4.w)} + acc[ai][bj][m][1];
                    acc[ai][bj][m][0] = o0; acc[ai][bj][m][1] = o1;
                    q += ((o0[0] * o0[0] + o0[1] * o0[1]) + (o0[2] * o0[2] + o0[3] * o0[3])) + ((o1[0] * o1[0] + o1[1] * o1[1]) + (o1[2] * o1[2] + o1[3] * o1[3]));
                }
                qv[ai * 4 + m] = q;
            }
            asm volatile("" ::: "memory");
        }
#pragma unroll
        for (int k = 0; k < 8; ++k) qv[k] += __shfl_xor(qv[k], 16);
#pragma unroll
        for (int k = 0; k < 8; ++k) qv[k] += __shfl_xor(qv[k], 32);
        LAS float* part = (LAS float*)(lds + STAGE_BYTES);
        LAS float* rsrow = part + 1024;
        if (fq == 0) {
#pragma unroll
            for (int k = 0; k < 8; ++k) part[wc * 256 + (k >> 2) * HALF + wr * 64 + (k & 3) * 16 + fr] = qv[k];
        }
        asm volatile("s_waitcnt lgkmcnt(0)" ::: "memory");
        __builtin_amdgcn_s_barrier();
        if (wr == 0) {
            const int row = wc * 64 + fq * 16 + fr;
            const float s = (part[row] + part[256 + row]) + (part[512 + row] + part[768 + row]);
            unsigned long long* sl = slots + (size_t)u.pm * 1024 + row;
            __hip_atomic_store(sl + u.pn * 256, ((unsigned long long)__float_as_uint(s) << 32) | 1ull, __ATOMIC_RELAXED, __HIP_MEMORY_SCOPE_AGENT);
            float tot = s;
#pragma unroll
            for (int j = 1; j < 4; ++j) {
                unsigned long long* p = sl + ((u.pn + j) & 3) * 256;
                unsigned long long v = __hip_atomic_load(p, __ATOMIC_RELAXED, __HIP_MEMORY_SCOPE_AGENT);
                for (unsigned sp = 0; (unsigned)v != 1u && sp < (1u << 22); ++sp) { __builtin_amdgcn_s_sleep(1); v = __hip_atomic_load(p, __ATOMIC_RELAXED, __HIP_MEMORY_SCOPE_AGENT); }
                tot += __uint_as_float((unsigned)(v >> 32));
            }
            rsrow[row] = __builtin_amdgcn_rsqf(tot * (1.0f / 1024.0f) + EPS);
        }
        asm volatile("s_waitcnt lgkmcnt(0)" ::: "memory");
        __builtin_amdgcn_s_barrier();
        f32x4 wv[2][2];
#pragma unroll
        for (int bj = 0; bj < 2; ++bj) { wv[bj][0] = *(const f32x4*)(w + col0 + bj * HALF); wv[bj][1] = *(const f32x4*)(w + col0 + bj * HALF + 4); }
#pragma unroll
        for (int ai = 0; ai < 2; ++ai)
#pragma unroll
            for (int m = 0; m < 4; ++m) {
                const int rl = ai * HALF + wr * 64 + m * 16 + fr;
                const float rs = rsrow[rl];
                float* yp = Y + (size_t)(u.pm * BM + rl) * D + col0;
#pragma unroll
                for (int bj = 0; bj < 2; ++bj) {
                    PG8_ST((f32x4*)(yp + bj * HALF), acc[ai][bj][m][0] * rs * wv[bj][0]);
                    PG8_ST((f32x4*)(yp + bj * HALF + 4), acc[ai][bj][m][1] * rs * wv[bj][1]);
                }
            }
    }
};

enum { TAIL_SCALE = 0, TAIL_SWIGLU = 1, TAIL_RES = 2 };
struct TailArgs { const bf16_t* A; const bf16_t* Bt; int K; int N;
                  bf16_t* O; int ldo; const float* ss_in;
                  const bf16_t* base; bf16_t* XB; float* ss_out;
                  int cp_phase; const f32x4* cp_src[2]; f32x4* cp_dst[2]; };
template <int MODE>
DI void gemm_tail(const TailArgs& t, int G) {
    int tid = threadIdx.x; asm volatile("" : "+v"(tid));
    const int lane = tid & 63, wave = __builtin_amdgcn_readfirstlane(tid >> 6), fr = lane & 15, fq = lane >> 4;
    const int NT = t.N / 16, nitems = 8 * NT, K = t.K;
    for (int it = wave * G + (int)blockIdx.x; it < nitems; it += 8 * G) {
        const int mt = it & 7, nt = it >> 3;
        const bf16_t* ap = t.A + (size_t)(MP + 16 * mt + fr) * K + 8 * fq;
        int brow;
        if (MODE == TAIL_SWIGLU) brow = (nt >> 3) * 256 + (nt & 7) * 16 + fr; else brow = 16 * nt + fr;
        const bf16_t* bp = t.Bt + (size_t)brow * K + 8 * fq;
        f32x4 acc0 = (f32x4){0.f, 0.f, 0.f, 0.f}, acc1 = acc0;
        constexpr int KS = (MODE == TAIL_SWIGLU) ? 4 : 8, KB = 32 * KS;
        bf16x8 av[2][KS], bv[2][KS], cv[2][KS];
#define TL_LOAD(buf, kk) do { _Pragma("unroll") for (int ks = 0; ks < KS; ++ks) { av[buf][ks] = *(const bf16x8*)(ap + (kk) + 32 * ks); bv[buf][ks] = *(const bf16x8*)(bp + (kk) + 32 * ks); \
            if (MODE == TAIL_SWIGLU) cv[buf][ks] = *(const bf16x8*)(bp + (size_t)128 * K + (kk) + 32 * ks); } } while (0)
#define TL_MMA(buf) do { _Pragma("unroll") for (int ks = 0; ks < KS; ++ks) { acc0 = __builtin_amdgcn_mfma_f32_16x16x32_bf16(bv[buf][ks], av[buf][ks], acc0, 0, 0, 0); \
            if (MODE == TAIL_SWIGLU) acc1 = __builtin_amdgcn_mfma_f32_16x16x32_bf16(cv[buf][ks], av[buf][ks], acc1, 0, 0, 0); } } while (0)
#define TL_SB __builtin_amdgcn_sched_barrier(0)
        TL_LOAD(0, 0);
        int k0 = 0;
        for (; k0 + 2 * KB <= K; k0 += 2 * KB) { TL_SB; TL_LOAD(1, k0 + KB); TL_SB; TL_MMA(0); TL_SB; if (k0 + 2 * KB < K) TL_LOAD(0, k0 + 2 * KB); TL_SB; TL_MMA(1); }
        TL_SB;
        if (k0 < K) TL_MMA(0);
#undef TL_SB
#undef TL_LOAD
#undef TL_MMA
        const int m = 16 * mt + fr, c = 16 * nt + 4 * fq;
        if (MODE == TAIL_SCALE) {
            const float rs = __builtin_amdgcn_rsqf(t.ss_in[MP + m] * (1.0f / 1024.0f) + EPS);
            *(u32x2*)(t.O + (size_t)(MP + m) * t.ldo + c) = (u32x2){pk2(acc0[0] * rs, acc0[1] * rs), pk2(acc0[2] * rs, acc0[3] * rs)};
        } else if (MODE == TAIL_SWIGLU) {
            const float rs = __builtin_amdgcn_rsqf(t.ss_in[MP + m] * (1.0f / 1024.0f) + EPS);
            float hv[4];
#pragma unroll
            for (int j = 0; j < 4; ++j) { const float g = acc0[j] * rs, up = acc1[j] * rs; hv[j] = g * __builtin_amdgcn_rcpf(1.f + __expf(-g)) * up; }
            *(u32x2*)(t.O + (size_t)(MP + m) * t.ldo + c) = (u32x2){pk2(hv[0], hv[1]), pk2(hv[2], hv[3])};
        } else {
            const u32x2 b2 = *(const u32x2*)(t.base + (size_t)(MP + m) * D + c);
            const f32x4 o = (f32x4){bflo(b2.x), bfhi(b2.x), bflo(b2.y), bfhi(b2.y)} + acc0;
            *(u32x2*)(t.XB + (size_t)(MP + m) * D + c) = (u32x2){pk2(o[0], o[1]), pk2(o[2], o[3])};
            float q = (o[0] * o[0] + o[1] * o[1]) + (o[2] * o[2] + o[3] * o[3]);
            q += __shfl_xor(q, 16); q += __shfl_xor(q, 32);
            if (fq == 0) atomicAdd(t.ss_out + MP + m, q);
        }
    }
    if (MODE == TAIL_RES && t.cp_phase >= 0) {
        const int widx = wave * G + (int)blockIdx.x, nidle = 8 * G - nitems;
        if (widx >= nitems && nidle > 0) {
            const int total = 2 * 128 * 8128, nsl = 4 * nidle, sl = t.cp_phase * nidle + (widx - nitems);
            const int per = (total + nsl - 1) / nsl, p0 = sl * per, p1 = (p0 + per < total) ? p0 + per : total;
            for (int pc = p0 + lane; pc < p1; pc += 64) { const int tsel = pc >= 128 * 8128, off = pc - tsel * 128 * 8128, smp = off / 8128, w = off - smp * 8128;
                (tsel ? t.cp_dst[1] : t.cp_dst[0])[smp * 8192 + w] = (tsel ? t.cp_src[1] : t.cp_src[0])[smp * 8192 + 64 + w]; }
        }
    }
}

DI void gemm_tail_res(const TailArgs& t, int G, LAS unsigned char* lds) {
    int tid = threadIdx.x; asm volatile("" : "+v"(tid));
    const int lane = tid & 63, wave = __builtin_amdgcn_readfirstlane(tid >> 6), fr = lane & 15, fq = lane >> 4;
    const int K = t.K, ntiles = 8 * (t.N / 16), nch = K >> 8, half = wave >> 2, split = wave & 3;
    LAS f32x4* red = (LAS f32x4*)lds;
    for (int pair = (int)blockIdx.x; 2 * pair < ntiles; pair += G) {
        const int tile = 2 * pair + half, mt = tile & 7, nt = tile >> 3;
        const bf16_t* ap = t.A + (size_t)(MP + 16 * mt + fr) * K + 8 * fq;
        const bf16_t* bp = t.Bt + (size_t)(16 * nt + fr) * K + 8 * fq;
        f32x4 acc0 = (f32x4){0.f, 0.f, 0.f, 0.f};
        bf16x8 av[2][8], bv[2][8];
#define TR_LOAD(buf, kk) do { _Pragma("unroll") for (int ks = 0; ks < 8; ++ks) { av[buf][ks] = *(const bf16x8*)(ap + (kk) + 32 * ks); bv[buf][ks] = *(const bf16x8*)(bp + (kk) + 32 * ks); } } while (0)
#define TR_MMA(buf) do { _Pragma("unroll") for (int ks = 0; ks < 8; ++ks) acc0 = __builtin_amdgcn_mfma_f32_16x16x32_bf16(bv[buf][ks], av[buf][ks], acc0, 0, 0, 0); } while (0)
        int c = split;
        if (c < nch) TR_LOAD(0, c * 256);
        while (c < nch) {
            __builtin_amdgcn_sched_barrier(0);
            if (c + 4 < nch) TR_LOAD(1, (c + 4) * 256);
            __builtin_amdgcn_sched_barrier(0);
            TR_MMA(0);
            c += 4; if (c >= nch) break;
            __builtin_amdgcn_sched_barrier(0);
            if (c + 4 < nch) TR_LOAD(0, (c + 4) * 256);
            __builtin_amdgcn_sched_barrier(0);
            TR_MMA(1);
            c += 4;
        }
#undef TR_LOAD
#undef TR_MMA
        if (split > 0) red[(half * 3 + split - 1) * 64 + lane] = acc0;
        __syncthreads();
        if (split == 0) {
            acc0 += (red[(half * 3 + 0) * 64 + lane] + red[(half * 3 + 1) * 64 + lane]) + red[(half * 3 + 2) * 64 + lane];
            const int m = 16 * mt + fr, cc = 16 * nt + 4 * fq;
            const u32x2 b2 = *(const u32x2*)(t.base + (size_t)(MP + m) * D + cc);
            const f32x4 o = (f32x4){bflo(b2.x), bfhi(b2.x), bflo(b2.y), bfhi(b2.y)} + acc0;
            *(u32x2*)(t.XB + (size_t)(MP + m) * D + cc) = (u32x2){pk2(o[0], o[1]), pk2(o[2], o[3])};
            float q = (o[0] * o[0] + o[1] * o[1]) + (o[2] * o[2] + o[3] * o[3]);
            q += __shfl_xor(q, 16); q += __shfl_xor(q, 32);
            if (fq == 0) atomicAdd(t.ss_out + MP + m, q);
        }
        if (2 * (pair + G) < ntiles) __syncthreads();
    }
    if (t.cp_phase >= 0 && split > 0) {
        const int nw = 6 * G, widx = (int)blockIdx.x * 6 + half * 3 + (split - 1);
        const int total = 2 * 128 * 8128, nsl = 4 * nw, sl = t.cp_phase * nw + widx;
        const int per = (total + nsl - 1) / nsl, p0 = sl * per, p1 = (p0 + per < total) ? p0 + per : total;
        for (int pb = p0 + lane; pb < p1; pb += 6 * 64) {
            f32x4 tmp[6];
#pragma unroll
            for (int j = 0; j < 6; ++j) { const int pc = pb + 64 * j; if (pc < p1) { const int tsel = pc >= 128 * 8128, off = pc - tsel * 128 * 8128, smp = off / 8128, w = off - smp * 8128;
                tmp[j] = (tsel ? t.cp_src[1] : t.cp_src[0])[smp * 8192 + 64 + w]; } }
            __builtin_amdgcn_sched_barrier(0);
#pragma unroll
            for (int j = 0; j < 6; ++j) { const int pc = pb + 64 * j; if (pc < p1) { const int tsel = pc >= 128 * 8128, off = pc - tsel * 128 * 8128, smp = off / 8128, w = off - smp * 8128;
                (tsel ? t.cp_dst[1] : t.cp_dst[0])[smp * 8192 + w] = tmp[j]; } }
        }
    }
    __syncthreads();
}

template <class Epi>
DI void gemm_phase(LAS unsigned char* lds, const Gemm g, const StaticOrder& S, const Epi& E) {
    const int tid = threadIdx.x, wid = __builtin_amdgcn_readfirstlane(tid >> 6), lane = tid & 63, wr = wid >> 2, wc = wid & 3, fr = lane & 15, fq = lane >> 4;
    const int K = g.K, nt = K / BK;
    unsigned voffA[2], voffB[2];
#pragma unroll
    for (int i = 0; i < 2; ++i) { int R, C; stage_rc(tid * 16 + i * 8192, R, C); const int Rb = Epi::PERM ? ((R & ~31) + perm32(R & 31)) : R;
        voffA[i] = (unsigned)(R * K + C) * 2u; voffB[i] = (unsigned)(Rb * K + C) * 2u; }
    const size_t kstep = (size_t)(BK * 2);
    const size_t hstep = (size_t)HALF * K * 2;
    const size_t tstep = 2 * hstep;
    const unsigned ldsw = (unsigned)wid * 1024u;
    const int aoff = lds_byte(wr * 64 + fr, fq * 8), boff = lds_byte(wc * 32 + fr, fq * 8);
#define PG8_SA(b, h) (((b) * 2 + (h)) * HTB)
#define PG8_SB(b, h) ((4 + (b) * 2 + (h)) * HTB)
#define PG8_STAGE(bufoff, gbase, voff) do { _Pragma("unroll") for (int _i = 0; _i < 2; ++_i) \
        __builtin_amdgcn_global_load_lds((const unsigned*)((const char*)(gbase) + (voff)[_i]), (LAS unsigned*)(lds + (bufoff) + ldsw + _i * 8192), 16, 0, 0); } while (0)
#define PG8_LDA(dst, b, h) do { _Pragma("unroll") for (int m = 0; m < 4; ++m) _Pragma("unroll") for (int k = 0; k < 2; ++k) dst[m][k] = *(const LAS bf16x8*)(lds + PG8_SA(b, h) + aoff + m * 2048 + k * 1024); } while (0)
#define PG8_LDB(dst, b, h) do { _Pragma("unroll") for (int n = 0; n < 2; ++n) _Pragma("unroll") for (int k = 0; k < 2; ++k) dst[n][k] = *(const LAS bf16x8*)(lds + PG8_SB(b, h) + boff + n * 2048 + k * 1024); } while (0)
#define PG8_MMA(ai, bj, At, Bt) do { __builtin_amdgcn_s_setprio(1); _Pragma("unroll") for (int m = 0; m < 4; ++m) _Pragma("unroll") for (int n = 0; n < 2; ++n) _Pragma("unroll") for (int k = 0; k < 2; ++k) \
        acc[ai][bj][m][n] = __builtin_amdgcn_mfma_f32_16x16x32_bf16(Bt[n][k], At[m][k], acc[ai][bj][m][n], 0, 0, 0); __builtin_amdgcn_s_setprio(0); } while (0)
#define PG8_WAIT_V(n) asm volatile("s_waitcnt vmcnt(" #n ")" ::: "memory")
#define PG8_WAIT_L(n) asm volatile("s_waitcnt lgkmcnt(" #n ")" ::: "memory")
#define PG8_BAR __builtin_amdgcn_s_barrier()
#define PG8_SCHED __builtin_amdgcn_sched_barrier(0)
    Unit cur, nxt; int ui = 0;
    if (!S.next(0, cur)) return;
    f32x4 acc[2][2][4][2];
#pragma unroll
    for (int a = 0; a < 2; ++a)
#pragma unroll
        for (int b = 0; b < 2; ++b)
#pragma unroll
            for (int m = 0; m < 4; ++m)
#pragma unroll
                for (int n = 0; n < 2; ++n) acc[a][b][m][n] = (f32x4){0.f, 0.f, 0.f, 0.f};
    bf16x8 At[4][2], B0[2][2], B1[2][2];
    float pre[8];
    const char* cA = (const char*)g.A + (size_t)cur.pm * tstep; const char* cB = (const char*)g.Bt + (size_t)cur.pn * tstep;
    if (PG8_SP2) {
        PG8_STAGE(PG8_SB(0, 0), cB, voffB); PG8_STAGE(PG8_SB(0, 1), cB + hstep, voffB); PG8_STAGE(PG8_SA(0, 0), cA, voffA); PG8_STAGE(PG8_SA(0, 1), cA + hstep, voffA);
        if (wr == 1) PG8_BAR;
        PG8_WAIT_V(2); PG8_BAR;
        PG8_STAGE(PG8_SB(1, 0), cB + kstep, voffB); PG8_STAGE(PG8_SA(1, 0), cA + kstep, voffA); PG8_STAGE(PG8_SB(1, 1), cB + hstep + kstep, voffB);
        PG8_WAIT_V(6); PG8_BAR;
    } else {
    PG8_STAGE(PG8_SB(0, 0), cB, voffB); PG8_STAGE(PG8_SA(0, 0), cA, voffA); PG8_STAGE(PG8_SB(0, 1), cB + hstep, voffB); PG8_STAGE(PG8_SA(0, 1), cA + hstep, voffA);
    if (wr == 1) PG8_BAR;
    PG8_WAIT_V(4); PG8_BAR;
    PG8_STAGE(PG8_SB(1, 0), cB + kstep, voffB); PG8_STAGE(PG8_SA(1, 0), cA + kstep, voffA); PG8_STAGE(PG8_SB(1, 1), cB + hstep + kstep, voffB);
    PG8_WAIT_V(6); PG8_BAR;
    }
    for (;;) {
        const bool has_next = S.next(ui + 1, nxt);
        const char* nA = has_next ? (const char*)g.A + (size_t)nxt.pm * tstep : cA; const char* nB = has_next ? (const char*)g.Bt + (size_t)nxt.pn * tstep : cB;
        for (int t = 0; t < nt; t += 2) {
            const bool last = (t == nt - 2);
            const char* a1 = cA + (size_t)(t + 1) * kstep;
            const char* a2 = last ? nA : cA + (size_t)(t + 2) * kstep; const char* b2 = last ? nB : cB + (size_t)(t + 2) * kstep;
            const char* a3 = a2 + kstep; const char* b3 = b2 + kstep;
            if (last) E.prefetch(pre, cur, wr, fr);
            if (PG8_SP2) {
            PG8_LDB(B0, 0, 0); PG8_LDB(B1, 0, 1); PG8_SCHED; PG8_LDA(At, 0, 0); PG8_STAGE(PG8_SA(1, 1), a1 + hstep, voffA);
            PG8_WAIT_V(8); PG8_WAIT_L(0); PG8_BAR; PG8_MMA(0, 0, At, B0); PG8_MMA(0, 1, At, B1); PG8_BAR; PG8_SCHED;
            PG8_LDA(At, 0, 1); PG8_STAGE(PG8_SB(0, 0), b2, voffB); PG8_STAGE(PG8_SB(0, 1), b2 + hstep, voffB); PG8_STAGE(PG8_SA(0, 0), a2, voffA);
            PG8_WAIT_V(8); PG8_WAIT_L(0); PG8_BAR; PG8_MMA(1, 0, At, B0); PG8_MMA(1, 1, At, B1); PG8_BAR; PG8_SCHED;
            PG8_LDB(B0, 1, 0); PG8_LDB(B1, 1, 1); PG8_SCHED; PG8_LDA(At, 1, 0); PG8_STAGE(PG8_SA(0, 1), a2 + hstep, voffA);
            PG8_WAIT_V(8); PG8_WAIT_L(0); PG8_BAR; PG8_MMA(0, 0, At, B0); PG8_MMA(0, 1, At, B1); PG8_BAR; PG8_SCHED;
            PG8_LDA(At, 1, 1); PG8_STAGE(PG8_SB(1, 0), b3, voffB); PG8_STAGE(PG8_SB(1, 1), b3 + hstep, voffB); PG8_STAGE(PG8_SA(1, 0), a3, voffA);
            PG8_WAIT_V(8); PG8_WAIT_L(0); PG8_BAR; PG8_MMA(1, 0, At, B0); PG8_MMA(1, 1, At, B1); PG8_BAR; PG8_SCHED;
            } else {
            PG8_LDB(B0, 0, 0); PG8_SCHED; PG8_LDA(At, 0, 0); PG8_STAGE(PG8_SA(1, 1), a1 + hstep, voffA);
            PG8_WAIT_L(8); PG8_BAR; PG8_WAIT_L(0); PG8_MMA(0, 0, At, B0); PG8_BAR; PG8_SCHED;
            PG8_LDB(B1, 0, 1); PG8_STAGE(PG8_SB(0, 0), b2, voffB);
            PG8_BAR; PG8_WAIT_L(0); PG8_MMA(0, 1, At, B1); PG8_BAR;
            PG8_LDA(At, 0, 1); PG8_STAGE(PG8_SA(0, 0), a2, voffA);
            PG8_BAR; PG8_WAIT_L(0); PG8_MMA(1, 0, At, B0); PG8_BAR; PG8_SCHED;
            PG8_STAGE(PG8_SB(0, 1), b2 + hstep, voffB);
            PG8_WAIT_V(6); PG8_BAR; PG8_MMA(1, 1, At, B1); PG8_BAR;
            PG8_LDB(B0, 1, 0); PG8_SCHED; PG8_LDA(At, 1, 0); PG8_STAGE(PG8_SA(0, 1), a2 + hstep, voffA);
            PG8_WAIT_L(8); PG8_BAR; PG8_WAIT_L(0); PG8_MMA(0, 0, At, B0); PG8_BAR; PG8_SCHED;
            PG8_LDB(B1, 1, 1); PG8_STAGE(PG8_SB(1, 0), b3, voffB);
            PG8_BAR; PG8_WAIT_L(0); PG8_MMA(0, 1, At, B1); PG8_BAR;
            PG8_LDA(At, 1, 1); PG8_STAGE(PG8_SA(1, 0), a3, voffA);
            PG8_BAR; PG8_WAIT_L(0); PG8_MMA(1, 0, At, B0); PG8_BAR; PG8_SCHED;
            PG8_STAGE(PG8_SB(1, 1), b3 + hstep, voffB);
            PG8_WAIT_V(6); PG8_BAR; PG8_MMA(1, 1, At, B1); PG8_BAR;
            }
        }
        if (PG8_ALIGN_EPI) { if (wr == 0) PG8_BAR; }
        E(acc, cur, wr, wc, fr, fq, pre);
        if (!has_next) break;
#pragma unroll
        for (int a = 0; a < 2; ++a)
#pragma unroll
            for (int b = 0; b < 2; ++b)
#pragma unroll
                for (int m = 0; m < 4; ++m)
#pragma unroll
                    for (int n = 0; n < 2; ++n) acc[a][b][m][n] = (f32x4){0.f, 0.f, 0.f, 0.f};
        cur = nxt; cA = nA; cB = nB; ++ui;
        if (PG8_ALIGN_EPI) { if (wr == 1) PG8_BAR; }
    }
    PG8_WAIT_V(0);
    if (!PG8_ALIGN_EPI) { if (wr == 0) PG8_BAR; }
    PG8_BAR;
#undef PG8_SA
#undef PG8_SB
#undef PG8_STAGE
#undef PG8_LDA
#undef PG8_LDB
#undef PG8_MMA
#undef PG8_WAIT_V
#undef PG8_WAIT_L
#undef PG8_BAR
#undef PG8_SCHED
}
}
struct TrJob { const float* W; int ldw; int K; const float* sc; bf16_t* WT; int nblk32; int kind; };
DI int tr_src_col(int kind, int d0) {
    if (kind == 1) return d0 < 2048 ? d0 : d0 + 8;
    if (kind == 2) { const int pn = d0 >> 8, c0 = d0 & 255; return c0 < 128 ? pn * 128 + c0 : FF + pn * 128 + (c0 - 128); }
    return d0;
}
struct TrItem { const float* src; const float* sc; bf16_t* dst; int ldw; int K; };
DI void p0_tr_decode(const TrJob (&J)[8], const int (&cnt)[8], int it, TrItem& T) {
    int r = it; T.src = nullptr;
#pragma unroll
    for (int j = 0; j < 8; ++j) {
        if (r >= 0 && r < cnt[j]) { const int nb64 = J[j].nblk32 >> 1, kb = r / nb64, nb = r % nb64, k0 = 64 * kb, d0 = 64 * nb, n0 = tr_src_col(J[j].kind, d0);
            T.src = J[j].W + (size_t)k0 * J[j].ldw + n0; T.sc = J[j].sc ? J[j].sc + k0 : nullptr; T.dst = J[j].WT + (size_t)d0 * J[j].K + k0; T.ldw = J[j].ldw; T.K = J[j].K; r = -1; }
        else if (r >= 0) r -= cnt[j];
    }
}
#define P0_TR_LOAD(V, T) do { _Pragma("unroll") for (int i = 0; i < 16; ++i) V[i] = *(const f32x4*)((T).src + (size_t)(4 * i + (lane >> 4)) * (T).ldw + 4 * (lane & 15)); } while (0)
DI void p0_tr_finish(const f32x4 (&V)[16], const TrItem& T, LAS float* scr, int lane) {
    float scv[16];
#pragma unroll
    for (int i = 0; i < 16; ++i) scv[i] = 1.0f;
    if (T.sc) {
#pragma unroll
        for (int i = 0; i < 16; ++i) scv[i] = T.sc[4 * i + (lane >> 4)];
    }
    __builtin_amdgcn_sched_barrier(0);
#pragma unroll
    for (int i = 0; i < 16; ++i) { const int kk = 4 * i + (lane >> 4); const f32x4 v = V[i] * scv[i];
        LAS float* d = scr + kk * 65 + 4 * (lane & 15); d[0] = v[0]; d[1] = v[1]; d[2] = v[2]; d[3] = v[3]; }
    asm volatile("s_waitcnt lgkmcnt(0)" ::: "memory");
    const int c = lane & 7;
#pragma unroll
    for (int j = 0; j < 8; ++j) { const int n = (lane >> 3) + 8 * j; const LAS float* s = scr + (8 * c) * 65 + n;
        u32x4 o; o.x = pk2(s[0 * 65], s[1 * 65]); o.y = pk2(s[2 * 65], s[3 * 65]); o.z = pk2(s[4 * 65], s[5 * 65]); o.w = pk2(s[6 * 65], s[7 * 65]);
        *(u32x4*)(T.dst + (size_t)n * T.K + 8 * c) = o; }
    asm volatile("s_waitcnt lgkmcnt(0)" ::: "memory");
}
DI void p0_prologue(const Params& P, LAS unsigned char* lds, int vcu, int G) {
    int tid = threadIdx.x; asm volatile("" : "+v"(tid)); const int lane = tid & 63, wave = __builtin_amdgcn_readfirstlane(tid >> 6);
    LAS float* scr = (LAS float*)(lds + wave * 16896);
    const int gw = vcu * 8 + wave, NGW = G * 8;
    bf16_t* Wb = (bf16_t*)(P.ws + WS_W);
    {
        int cnt[8]; TrJob J[8];
        J[0] = TrJob{P.in[I_WIN], 3080, D, P.in[I_NMIX], Wb + W_IN, NIN / 32, 1};
        J[1] = TrJob{P.in[I_WOUTAB], D, D, nullptr, Wb + W_OUTAB, D / 32, 0};
        J[2] = TrJob{P.in[I_WGU], NGU, D, P.in[I_NFFN], Wb + W_GU0, NGU / 32, 2};
        J[3] = TrJob{P.in[I_WGU] + (size_t)D * NGU, NGU, D, P.in[I_NFFN] + D, Wb + W_GU1, NGU / 32, 2};
        J[4] = TrJob{P.in[I_WDN], D, FF, nullptr, Wb + W_DN0, D / 32, 0};
        J[5] = TrJob{P.in[I_WDN] + (size_t)FF * D, D, FF, nullptr, Wb + W_DN1, D / 32, 0};
        J[6] = TrJob{P.in[I_WQKV], NQKV, D, P.in[I_NMIX] + D, Wb + W_QKV, NQKV / 32, 0};
        J[7] = TrJob{P.in[I_WOUTC], D, D, nullptr, Wb + W_OUTC, D / 32, 0};
        int total = 0;
#pragma unroll
        for (int j = 0; j < 8; ++j) { cnt[j] = (J[j].nblk32 >> 1) * (J[j].K / 64); total += cnt[j]; }
        f32x4 VA[16], VB[16]; TrItem TA, TB;
        int it = gw;
        if (it < total) { p0_tr_decode(J, cnt, it, TA); P0_TR_LOAD(VA, TA); }
        while (it < total) {
            const int itb = it + NGW;
            if (itb < total) { p0_tr_decode(J, cnt, itb, TB); P0_TR_LOAD(VB, TB); }
            p0_tr_finish(VA, TA, scr, lane);
            const int ita = itb + NGW;
            if (ita < total) { p0_tr_decode(J, cnt, ita, TA); P0_TR_LOAD(VA, TA); }
            if (itb < total) p0_tr_finish(VB, TB, scr, lane);
            it = ita;
        }
    }
    {
        bf16_t* XB = (bf16_t*)P.out; float* ss0 = (float*)(P.ws + WS_SS); float* BA = (float*)(P.ws + WS_BA);
        const float* nm = P.in[I_NMIX]; const float* win = P.in[I_WIN];
        float wq[4][4][8];
#pragma unroll
        for (int j = 0; j < 4; ++j)
#pragma unroll
            for (int e = 0; e < 4; ++e) { const int k = 256 * j + 4 * lane + e; const float gk = nm[k];
                const f32x4 a = *(const f32x4*)(win + (size_t)k * 3080 + 2048), b = *(const f32x4*)(win + (size_t)k * 3080 + 2052);
                wq[j][e][0] = a[0] * gk; wq[j][e][1] = a[1] * gk; wq[j][e][2] = a[2] * gk; wq[j][e][3] = a[3] * gk;
                wq[j][e][4] = b[0] * gk; wq[j][e][5] = b[1] * gk; wq[j][e][6] = b[2] * gk; wq[j][e][7] = b[3] * gk; }
        f32x4 va[4], vb[4];
#define P0_ROW_LOAD(V, m_) do { const float* xr_ = ((m_) < MP) ? P.in[I_XP] + (size_t)(m_) * D : P.in[I_XS] + (size_t)((m_) - MP) * D; \
            _Pragma("unroll") for (int j = 0; j < 4; ++j) V[j] = *((const f32x4*)xr_ + 64 * j + lane); } while (0)
#define P0_ROW_BODY(V, m, mnext) do { \
            f32x4 v[4]; float s = 0.f; float dacc[8]; \
            _Pragma("unroll") for (int j = 0; j < 4; ++j) v[j] = V[j]; \
            if ((mnext) < MREAL) P0_ROW_LOAD(V, (mnext)); \
            _Pragma("unroll") for (int c = 0; c < 8; ++c) dacc[c] = 0.f; \
            _Pragma("unroll") for (int j = 0; j < 4; ++j) { s += (v[j][0] * v[j][0] + v[j][1] * v[j][1]) + (v[j][2] * v[j][2] + v[j][3] * v[j][3]); \
                _Pragma("unroll") for (int e = 0; e < 4; ++e) \
                    _Pragma("unroll") for (int c = 0; c < 8; ++c) dacc[c] += v[j][e] * wq[j][e][c]; } \
            s = wave_sum(s); \
              \
            float t4[4], t2[2], t1; \
            { const bool hi = lane & 1; _Pragma("unroll") for (int c = 0; c < 4; ++c) { const float snd = hi ? dacc[c] : dacc[c + 4], kp = hi ? dacc[c + 4] : dacc[c]; t4[c] = kp + __shfl_xor(snd, 1); } } \
            { const bool hi = lane & 2; _Pragma("unroll") for (int c = 0; c < 2; ++c) { const float snd = hi ? t4[c] : t4[c + 2], kp = hi ? t4[c + 2] : t4[c]; t2[c] = kp + __shfl_xor(snd, 2); } } \
            { const bool hi = lane & 4; const float snd = hi ? t2[0] : t2[1], kp = hi ? t2[1] : t2[0]; t1 = kp + __shfl_xor(snd, 4); } \
            t1 += __shfl_xor(t1, 8); t1 += __shfl_xor(t1, 16); t1 += __shfl_xor(t1, 32); \
            const float rs = rsqrtf(s * (1.0f / 1024.0f) + EPS); \
            u32x2* o8 = (u32x2*)(XB + (size_t)(m) * D) + lane; \
            _Pragma("unroll") for (int j = 0; j < 4; ++j) { u32x2 w; w.x = pk2(v[j][0], v[j][1]); w.y = pk2(v[j][2], v[j][3]); o8[64 * j] = w; } \
            if (lane == 0) ss0[(m)] = s; \
            if (lane < 8) BA[(size_t)(m) * 8 + 4 * (lane & 1) + 2 * ((lane >> 1) & 1) + ((lane >> 2) & 1)] = t1 * rs; \
        } while (0)
        f32x4 vc[4];
        if (gw < MREAL) P0_ROW_LOAD(va, gw);
        if (gw + NGW < MREAL) P0_ROW_LOAD(vb, gw + NGW);
        if (gw + 2 * NGW < MREAL) P0_ROW_LOAD(vc, gw + 2 * NGW);
        for (int m = gw; m < MREAL; m += 3 * NGW) {
            P0_ROW_BODY(va, m, m + 3 * NGW);
            if (m + NGW < MREAL) P0_ROW_BODY(vb, m + NGW, m + 4 * NGW);
            if (m + 2 * NGW < MREAL) P0_ROW_BODY(vc, m + 2 * NGW, m + 5 * NGW);
        }
#undef P0_ROW_BODY
#undef P0_ROW_LOAD
        float* ssz = (float*)(P.ws + WS_SS);
        for (int i = vcu * 512 + tid; i < 4 * MPAD; i += G * 512) ssz[MPAD + i] = 0.f;
        for (int i = vcu * 512 + tid; i < MPAD - MREAL; i += G * 512) ssz[MREAL + i] = 0.f;
    }
}
DI int swapb(int t) { return (t & ~12) | ((t & 4) << 1) | ((t & 8) >> 1); }
DI int img256(int row, int chunk) { return row * 256 + ((chunk ^ (row & 15)) << 4); }
DI int img128(int row, int chunk) { const int L = row >> 1, slot = ((row & 1) << 3) | chunk; return L * 256 + ((slot ^ (L & 15)) << 4); }

constexpr int GP_QF = 0, GP_AM = 0, GP_QKM = 17408, GP_KF = 33792, GP_VF = 67584, GP_QB = 101376, GP_KB = 118784, GP_SM = 136192, GP_AB = 137728, GP_TB = 146944;
constexpr int GP_CW = 149504;
constexpr int GDNI_WK = 0, GDNI_QD = 16384, GDNI_KT = 32768, GDNI_QK = 49152;

template <int MODE>
DI void gdn_prep_phase(const Params& P, LAS unsigned char* lds, int bx, int G) {
    int tid0 = threadIdx.x; asm volatile("" : "+v"(tid0)); const int wave = __builtin_amdgcn_readfirstlane(tid0 >> 6);
    int tid = tid0; int lane = tid & 63;
    const bf16_t* proj = (const bf16_t*)(P.ws + WS_BIG);
    LAS float* SSQ = (LAS float*)(lds + GP_SM); LAS float* SSK = SSQ + 64; LAS float* BETA = SSQ + 128; LAS float* GAM = SSQ + 192; LAS float* EG = SSQ + 256;
    if (bx >= NCHUNKS) return;
    int g48 = tid % 48, seg = tid / 48, which = g48 >> 4, cg = g48 & 15;
    u32x4 raw[11]; float bav = 0.f, aav = 0.f;
#define GP_LOAD(ci_) do { const int n_ = (ci_) & 31, h_ = ((ci_) >> 5) & 3, b_ = (ci_) >> 7, R0_ = b_ * TSEQ + n_ * 64; \
        if (tid < 384) { const int col_ = which * 512 + h_ * 128 + 8 * cg; \
            _Pragma("unroll") for (int j = 0; j < 11; ++j) { const int t = seg * 8 - 3 + j; raw[j] = (u32x4){0u, 0u, 0u, 0u}; \
                if (n_ > 0 || t >= 0) raw[j] = *(const u32x4*)(proj + (size_t)(R0_ + t) * NIN + col_); } } \
        else if (wave == 6) { const float* BA_ = (const float*)(P.ws + WS_BA) + (size_t)(R0_ + lane) * 8; bav = BA_[h_]; aav = BA_[4 + h_]; } } while (0)
    GP_LOAD(bx);
    int hprev = -1;
  for (int ci = bx; ci < NCHUNKS; ci += G) {
    tid = tid0; asm volatile("" : "+v"(tid));
    lane = tid & 63; g48 = tid % 48; seg = tid / 48; which = g48 >> 4; cg = g48 & 15;
    const int n = ci & 31, h = (ci >> 5) & 3, b = ci >> 7;
    const int R0 = b * TSEQ + n * 64;
    unsigned char* gout = MODE ? P.ws + 494 * MiB + (size_t)(ci & 127) * GDNI_STG : P.ws + WS_GDNI + (size_t)ci * GDNI_STG;
    BAR_LDS();
    if (tid >= 448) { const int t = tid - 448; SSQ[t] = 0.f; SSK[t] = 0.f; }
    if (h != hprev) { hprev = h;
        for (int e = tid; e < 4 * 384; e += 512) { const int j = e / 384, c = e - j * 384; ((LAS float*)(lds + GP_CW))[e] = P.in[I_CONVG][j * 1536 + (c >> 7) * 512 + h * 128 + (c & 127)]; } }
    BAR_LDS();
    f32x4 cw[4][2];
    if (tid < 384) {
#pragma unroll
        for (int j = 0; j < 4; ++j) { const LAS float* cp = (const LAS float*)(lds + GP_CW) + j * 384 + which * 128 + 8 * cg; cw[j][0] = *(const LAS f32x4*)cp; cw[j][1] = *(const LAS f32x4*)(cp + 4); } }
    if (tid < 384 && !(MODE & 2)) {
#pragma unroll
        for (int tt = 0; tt < 8; ++tt) {
            float y[8];
#pragma unroll
            for (int e = 0; e < 8; ++e) y[e] = 0.f;
#pragma unroll
            for (int j = 0; j < 4; ++j) { const u32x4 w = raw[tt + j];
                y[0] += cw[j][0][0] * bflo(w.x); y[1] += cw[j][0][1] * bfhi(w.x); y[2] += cw[j][0][2] * bflo(w.y); y[3] += cw[j][0][3] * bfhi(w.y);
                y[4] += cw[j][1][0] * bflo(w.z); y[5] += cw[j][1][1] * bfhi(w.z); y[6] += cw[j][1][2] * bflo(w.w); y[7] += cw[j][1][3] * bfhi(w.w); }
            float q = 0.f;
#pragma unroll
            for (int e = 0; e < 8; ++e) { y[e] = siluf_(y[e]); q += y[e] * y[e]; }
            const int t = seg * 8 + tt;
            LAS float* dst = (LAS float*)(lds + (which == 0 ? GP_QF : (which == 1 ? GP_KF : GP_VF))) + t * 132 + 8 * cg;
            *(LAS f32x4*)dst = (f32x4){y[0], y[1], y[2], y[3]}; *(LAS f32x4*)(dst + 4) = (f32x4){y[4], y[5], y[6], y[7]};
            if (which == 0) atomicAdd((float*)(SSQ + t), q); else if (which == 1) atomicAdd((float*)(SSK + t), q);
        }
    } else if (wave == 6) {
        const int t = lane;
        const float beta = sigmoidf_(bav);
        const float g = -__expf(P.in[I_ALOG][h]) * softplusf_(aav + P.in[I_DTB][h]);
        float c = g;
#pragma unroll
        for (int o = 1; o < 64; o <<= 1) { const float tv = __shfl_up(c, o); if (lane >= o) c += tv; }
        BETA[t] = beta; GAM[t] = c; EG[t] = __expf(c);
        if (lane == 63 && MODE == 0) ((float*)(P.ws + WS_GT))[ci] = __expf(c);
    }
    const u32x4* zsrc = (const u32x4*)(proj + (size_t)(R0 + (tid >> 3)) * NIN + 1536 + h * 128 + 16 * (tid & 7));
    const u32x4 zr0 = zsrc[0], zr1 = zsrc[1];
    if (ci + G < NCHUNKS) GP_LOAD(ci + G);
    BAR_LDS();
    if (!(MODE & 32))
#pragma unroll
    for (int rep = 0; rep < 4; ++rep) {
        const int idx = tid + 512 * (rep & 1), i = idx >> 4, sh = idx & 15, s = sh >> 1, hh = sh & 1, d0 = 16 * s + 4 * hh, d1 = d0 + 8;
        if (rep < 2) {
            LAS float* qf = (LAS float*)(lds + GP_QF) + i * 132;
            const float rn = rsqrtf(SSQ[i] + EPS) * 0.08838834764831845f;
            const f32x4 a = *(LAS f32x4*)(qf + d0) * rn, c = *(LAS f32x4*)(qf + d1) * rn;
            LAS bf16_t* qb = (LAS bf16_t*)(lds + GP_QB) + i * 136;
            *(LAS u32x2*)(qb + d0) = (u32x2){pk2(a[0], a[1]), pk2(a[2], a[3])}; *(LAS u32x2*)(qb + d1) = (u32x2){pk2(c[0], c[1]), pk2(c[2], c[3])};
            const float eg = EG[i]; const f32x4 ae = a * eg, ce = c * eg;
            *(u32x4*)(gout + GDNI_QD + img256(i, 2 * s + hh)) = (u32x4){pk2(ae[0], ae[1]), pk2(ae[2], ae[3]), pk2(ce[0], ce[1]), pk2(ce[2], ce[3])};
        } else {
            LAS float* kf = (LAS float*)(lds + GP_KF) + i * 132;
            const float rn = rsqrtf(SSK[i] + EPS);
            const f32x4 a = *(LAS f32x4*)(kf + d0) * rn, c = *(LAS f32x4*)(kf + d1) * rn;
            *(LAS f32x4*)(kf + d0) = a; *(LAS f32x4*)(kf + d1) = c;
            LAS bf16_t* kb = (LAS bf16_t*)(lds + GP_KB) + i * 136;
            *(LAS u32x2*)(kb + d0) = (u32x2){pk2(a[0], a[1]), pk2(a[2], a[3])}; *(LAS u32x2*)(kb + d1) = (u32x2){pk2(c[0], c[1]), pk2(c[2], c[3])};
        }
    }
    BAR_LDS();
    if (!(MODE & 4)) {
        const int sel = wave >> 2, mt = wave & 3, fr = lane & 15, fq = lane >> 4;
        const LAS unsigned char* abase = lds + (sel ? GP_QB : GP_KB) + (16 * mt + fr) * 272 + fq * 16;
        bf16x8 af[4];
#pragma unroll
        for (int ks = 0; ks < 4; ++ks) af[ks] = *(const LAS bf16x8*)(abase + ks * 64);
        f32x4 acc[4];
#pragma unroll
        for (int nt = 0; nt < 4; ++nt) { acc[nt] = (f32x4){0.f, 0.f, 0.f, 0.f};
            const LAS unsigned char* bbase = lds + GP_KB + (16 * nt + fr) * 272 + fq * 16;
#pragma unroll
            for (int ks = 0; ks < 4; ++ks) { const bf16x8 bfv = *(const LAS bf16x8*)(bbase + ks * 64); acc[nt] = __builtin_amdgcn_mfma_f32_16x16x32_bf16(af[ks], bfv, acc[nt], 0, 0, 0); } }
#pragma unroll
        for (int nt = 0; nt < 4; ++nt) { const int j = 16 * nt + fr; const float gj = GAM[j];
#pragma unroll
            for (int r = 0; r < 4; ++r) { const int i = 16 * mt + 4 * fq + r; const float dec = __expf(GAM[i] - gj);
                if (sel == 0) { const float a = (j < i) ? BETA[i] * acc[nt][r] * dec : 0.f;
                    if (nt == mt) ((LAS float*)(lds + GP_AM))[i * 68 + j] = a;
                    *((LAS bf16_t*)(lds + GP_AB) + i * 72 + j) = f2bf(-a); }
                else ((LAS float*)(lds + GP_QKM))[i * 64 + j] = (j <= i) ? acc[nt][r] * dec : 0.f; } }
    }
    BAR_LDS();
    if (wave == 7) {
        const int bb = lane >> 4, c = lane & 15;
        const LAS float* ab = (const LAS float*)(lds + GP_AM) + (16 * bb) * 68 + 16 * bb;
        float t[16];
#pragma unroll
        for (int i = 0; i < 16; ++i) {
            float s = (i == c) ? 1.f : 0.f;
#pragma unroll
            for (int j = 0; j < i; ++j) s -= ab[i * 68 + j] * t[j];
            t[i] = s;
        }
#pragma unroll
        for (int i = 0; i < 16; ++i) *((LAS bf16_t*)(lds + GP_TB) + (bb * 16 + i) * 16 + c) = f2bf(t[i]);
    } else if (!(MODE & 8)) {
        const float glast = GAM[63];
        for (int idx = tid; idx < 1024; idx += 448) {
            const int dk = idx & 127, chunk = idx >> 7, s = chunk >> 1, hh = chunk & 1;
            float v[8];
#pragma unroll
            for (int j = 0; j < 8; ++j) { const int i = 16 * s + 8 * (j >> 2) + 4 * hh + (j & 3); v[j] = ((const LAS float*)(lds + GP_KF))[i * 132 + dk] * __expf(glast - GAM[i]); }
            *(u32x4*)(gout + GDNI_KT + img128(dk, chunk)) = (u32x4){pk2(v[0], v[1]), pk2(v[2], v[3]), pk2(v[4], v[5]), pk2(v[6], v[7])};
        }
        for (int idx = tid; idx < 512; idx += 448) {
            const int i = idx >> 3, chunk = idx & 7, s = chunk >> 1, hh = chunk & 1, j0 = 16 * s + 4 * hh;
            const LAS float* qm = (const LAS float*)(lds + GP_QKM) + i * 64;
            const f32x4 a = *(const LAS f32x4*)(qm + j0), c = *(const LAS f32x4*)(qm + j0 + 8);
            *(u32x4*)(gout + GDNI_QK + img128(i, chunk)) = (u32x4){pk2(a[0], a[1]), pk2(a[2], a[3]), pk2(c[0], c[1]), pk2(c[2], c[3])};
        }
    }
    BAR_LDS();
    if (!(MODE & 1)) {
        const int fr = lane & 15, q = lane >> 4;
        f32x4 R[4][2]; unsigned Xp[4][2][2];
#pragma unroll
        for (int bk = 0; bk < 4; ++bk)
#pragma unroll
            for (int r = 0; r < 4; ++r) { const int i = 16 * bk + 4 * q + r; float bi = BETA[i]; if (wave >= 4) bi *= EG[i];
#pragma unroll
                for (int nt = 0; nt < 2; ++nt) { const int c = 32 * (wave & 3) + 16 * nt + fr;
                    R[bk][nt][r] = bi * ((const LAS float*)(lds + (wave < 4 ? GP_VF : GP_KF)))[i * 132 + c]; } }
        const u32x2 zz = (u32x2){0u, 0u};
#define RD_AB(row, col) (*(const LAS u32x2*)((const LAS bf16_t*)(lds + GP_AB) + (row) * 72 + (col)))
#define MK8(lo, hi) __builtin_bit_cast(bf16x8, (u32x4){(lo).x, (lo).y, (hi).x, (hi).y})
#pragma unroll
        for (int bk = 0; bk < 4; ++bk) {
            if (bk == 1) { const bf16x8 af = MK8(RD_AB(16 + fr, 4 * q), zz);
#pragma unroll
                for (int nt = 0; nt < 2; ++nt) { const u32x2 x0 = (u32x2){Xp[0][nt][0], Xp[0][nt][1]}; R[1][nt] = __builtin_amdgcn_mfma_f32_16x16x32_bf16(af, MK8(x0, zz), R[1][nt], 0, 0, 0); } }
            if (bk == 2) { const bf16x8 af = MK8(RD_AB(32 + fr, 4 * q), RD_AB(32 + fr, 16 + 4 * q));
#pragma unroll
                for (int nt = 0; nt < 2; ++nt) { const u32x2 x0 = (u32x2){Xp[0][nt][0], Xp[0][nt][1]}, x1 = (u32x2){Xp[1][nt][0], Xp[1][nt][1]};
                    R[2][nt] = __builtin_amdgcn_mfma_f32_16x16x32_bf16(af, MK8(x0, x1), R[2][nt], 0, 0, 0); } }
            if (bk == 3) { const bf16x8 af = MK8(RD_AB(48 + fr, 4 * q), RD_AB(48 + fr, 16 + 4 * q)), ag = MK8(RD_AB(48 + fr, 32 + 4 * q), zz);
#pragma unroll
                for (int nt = 0; nt < 2; ++nt) { const u32x2 x0 = (u32x2){Xp[0][nt][0], Xp[0][nt][1]}, x1 = (u32x2){Xp[1][nt][0], Xp[1][nt][1]}, x2 = (u32x2){Xp[2][nt][0], Xp[2][nt][1]};
                    R[3][nt] = __builtin_amdgcn_mfma_f32_16x16x32_bf16(af, MK8(x0, x1), R[3][nt], 0, 0, 0);
                    R[3][nt] = __builtin_amdgcn_mfma_f32_16x16x32_bf16(ag, MK8(x2, zz), R[3][nt], 0, 0, 0); } }
            const bf16x8 tf = MK8(*(const LAS u32x2*)((const LAS bf16_t*)(lds + GP_TB) + (bk * 16 + fr) * 16 + 4 * q), zz);
#pragma unroll
            for (int nt = 0; nt < 2; ++nt) {
                const u32x2 rp = (u32x2){pk2(R[bk][nt][0], R[bk][nt][1]), pk2(R[bk][nt][2], R[bk][nt][3])};
                R[bk][nt] = __builtin_amdgcn_mfma_f32_16x16x32_bf16(tf, MK8(rp, zz), (f32x4){0.f, 0.f, 0.f, 0.f}, 0, 0, 0);
                Xp[bk][nt][0] = pk2(R[bk][nt][0], R[bk][nt][1]); Xp[bk][nt][1] = pk2(R[bk][nt][2], R[bk][nt][3]);
            }
        }
#undef RD_AB
#undef MK8
        if (wave < 4) {
            unsigned char* wv = MODE ? P.ws + 502 * MiB + (size_t)(ci & 127) * 16384 : P.ws + WS_GDNWV + (size_t)ci * 16384;
#pragma unroll
            for (int bk = 0; bk < 4; ++bk)
#pragma unroll
                for (int nt = 0; nt < 2; ++nt)
                    *(u32x2*)(wv + ((((wave * 2 + (bk >> 1)) * 64 + (q & 1) * 32 + 16 * nt + fr) << 5) + (8 * (bk & 1) + 4 * (q >> 1)) * 2)) = (u32x2){Xp[bk][nt][0], Xp[bk][nt][1]};
        } else if (!(MODE & 16)) {
#pragma unroll
            for (int nt = 0; nt < 2; ++nt) { const int d = 32 * (wave - 4) + 16 * nt + fr, pos = swapb(d);
#pragma unroll
                for (int bk = 0; bk < 4; ++bk)
#pragma unroll
                    for (int r = 0; r < 4; ++r) { const int i = 16 * bk + 4 * q + r;
                        *(LAS bf16_t*)(lds + GP_QB + img256(i, pos >> 3) + (pos & 7) * 2) = f2bf(-R[bk][nt][r]); } }
        }
    }
    if (!(MODE & 16)) {
        BAR_LDS();
#pragma unroll
        for (int j = 0; j < 2; ++j) *(u32x4*)(gout + GDNI_WK + tid * 16 + 8192 * j) = *(const LAS u32x4*)(lds + GP_QB + tid * 16 + 8192 * j);
    }
    {
        const float* nwp = P.in[I_GNW] + 16 * (tid & 7);
        const f32x4 n0 = *(const f32x4*)nwp, n1 = *(const f32x4*)(nwp + 4), n2 = *(const f32x4*)(nwp + 8), n3 = *(const f32x4*)(nwp + 12);
        u32x4 o0, o1;
        o0.x = pk2(siluf_(bflo(zr0.x)) * n0[0], siluf_(bfhi(zr0.x)) * n0[1]); o0.y = pk2(siluf_(bflo(zr0.y)) * n0[2], siluf_(bfhi(zr0.y)) * n0[3]);
        o0.z = pk2(siluf_(bflo(zr0.z)) * n1[0], siluf_(bfhi(zr0.z)) * n1[1]); o0.w = pk2(siluf_(bflo(zr0.w)) * n1[2], siluf_(bfhi(zr0.w)) * n1[3]);
        o1.x = pk2(siluf_(bflo(zr1.x)) * n2[0], siluf_(bfhi(zr1.x)) * n2[1]); o1.y = pk2(siluf_(bflo(zr1.y)) * n2[2], siluf_(bfhi(zr1.y)) * n2[3]);
        o1.z = pk2(siluf_(bflo(zr1.z)) * n3[0], siluf_(bfhi(zr1.z)) * n3[1]); o1.w = pk2(siluf_(bflo(zr1.w)) * n3[2], siluf_(bfhi(zr1.w)) * n3[3]);
        u32x4* zd = (u32x4*)((MODE ? P.ws + 504 * MiB + (size_t)(ci & 127) * 16384 : P.ws + WS_ZS + (size_t)ci * 16384) + (size_t)(tid >> 3) * 256 + 32 * (tid & 7));
        zd[0] = o0; zd[1] = o1;
    }
  }
#undef GP_LOAD
}
DI bf16x8 pack_acc(const f32x16& x, int s) {
    u32x4 p;
    if (s == 0) { p.x = pk2(x[0], x[1]); p.y = pk2(x[2], x[3]); p.z = pk2(x[4], x[5]); p.w = pk2(x[6], x[7]); }
    else        { p.x = pk2(x[8], x[9]); p.y = pk2(x[10], x[11]); p.z = pk2(x[12], x[13]); p.w = pk2(x[14], x[15]); }
    return __builtin_bit_cast(bf16x8, p);
}
#ifndef SCAN_PRIO
#define SCAN_PRIO 0
#endif
constexpr int SC_STG0 = 0, SC_STG1 = 57344, SC_OB0 = 114688, SC_OB1 = 132096, SC_NW = 149504;
#define MFMA32(a, b, c) __builtin_amdgcn_mfma_f32_32x32x16_bf16((a), (b), (c), 0, 0, 0)

template <int MODE>
DI void gdn_scan_block(const Params& P, LAS unsigned char* lds, int gi) {
    int tid = threadIdx.x; asm volatile("" : "+v"(tid)); const int lane = tid & 63, wave = __builtin_amdgcn_readfirstlane(tid >> 6);
    const int h = gi & 3, b = gi >> 2, ci0 = gi * NCHUNK, Rb = b * TSEQ;
    const unsigned char* stg = P.ws + WS_GDNI + (size_t)ci0 * GDNI_STG;
    const bf16_t* proj = (const bf16_t*)(P.ws + WS_BIG);
    if (wave < 4) {
        const int r = lane & 31, hh = lane >> 5, w = wave;
#if SCAN_PRIO
        __builtin_amdgcn_s_setprio(SCAN_PRIO);
#endif
        f32x16 S[4];
#pragma unroll
        for (int T = 0; T < 4; ++T) S[T] = (f32x16){0.f, 0.f, 0.f, 0.f, 0.f, 0.f, 0.f, 0.f, 0.f, 0.f, 0.f, 0.f, 0.f, 0.f, 0.f, 0.f};
        u32x4 wvn[2][2]; float gtn;
        {
            const unsigned char* wv = P.ws + WS_GDNWV + (size_t)ci0 * 16384;
#pragma unroll
            for (int mt = 0; mt < 2; ++mt) { const u32x4* src = (const u32x4*)(wv + (((w * 2 + mt) * 64 + lane) << 5)); wvn[mt][0] = src[0]; wvn[mt][1] = src[1]; }
            gtn = ((const float*)(P.ws + WS_GT))[ci0];
        }
        BAR_LDS();
        for (int n = 0; n < NCHUNK; ++n) {
            const int cur = (n & 1) ? SC_STG1 : SC_STG0, ob = (n & 1) ? SC_OB1 : SC_OB0;
            if (MODE & 1) { BAR_LDS(); continue; }
            f32x16 U[2], O[2];
            const float gt = gtn;
#pragma unroll
            for (int mt = 0; mt < 2; ++mt) {
                const u32x4 a = wvn[mt][0], c = wvn[mt][1];
                U[mt][0] = bflo(a.x); U[mt][1] = bfhi(a.x); U[mt][2] = bflo(a.y); U[mt][3] = bfhi(a.y); U[mt][4] = bflo(a.z); U[mt][5] = bfhi(a.z); U[mt][6] = bflo(a.w); U[mt][7] = bfhi(a.w);
                U[mt][8] = bflo(c.x); U[mt][9] = bfhi(c.x); U[mt][10] = bflo(c.y); U[mt][11] = bfhi(c.y); U[mt][12] = bflo(c.z); U[mt][13] = bfhi(c.z); U[mt][14] = bflo(c.w); U[mt][15] = bfhi(c.w);
            }
            if (n + 1 < NCHUNK) {
                const unsigned char* wv = P.ws + WS_GDNWV + (size_t)(ci0 + n + 1) * 16384;
#pragma unroll
                for (int mt = 0; mt < 2; ++mt) { const u32x4* src = (const u32x4*)(wv + (((w * 2 + mt) * 64 + lane) << 5)); wvn[mt][0] = src[0]; wvn[mt][1] = src[1]; }
                gtn = ((const float*)(P.ws + WS_GT))[ci0 + n + 1];
            }
            __builtin_amdgcn_sched_barrier(0);
#define RD_WK(ks, mt) (*(const LAS bf16x8*)(lds + cur + GDNI_WK + img256(32 * (mt) + r, 2 * (ks) + hh)))
#define RD_QD(ks, mt) (*(const LAS bf16x8*)(lds + cur + GDNI_QD + img256(32 * (mt) + r, 2 * (ks) + hh)))
#define RD_QK(ks, mt) (*(const LAS bf16x8*)(lds + cur + GDNI_QK + img128(32 * (mt) + r, 2 * (ks) + hh)))
#define RD_KT(ks, T)  (*(const LAS bf16x8*)(lds + cur + GDNI_KT + img128(32 * (T) + r, 2 * (ks) + hh)))
#define SCHED_FENCE() __builtin_amdgcn_sched_barrier(0)
#define RD_UO(F, ks) do { F[0] = RD_WK(ks, 0); F[1] = RD_WK(ks, 1); F[2] = RD_QD(ks, 0); F[3] = RD_QD(ks, 1); } while (0)
#define MM_UO(F, ks) do { const bf16x8 sb_ = pack_acc(S[(ks) >> 1], (ks) & 1); U[0] = MFMA32(F[0], sb_, U[0]); U[1] = MFMA32(F[1], sb_, U[1]); O[0] = MFMA32(F[2], sb_, O[0]); O[1] = MFMA32(F[3], sb_, O[1]); } while (0)
            bf16x8 FA[4], FB[4], FC[4];
            O[0] = (f32x16){0.f, 0.f, 0.f, 0.f, 0.f, 0.f, 0.f, 0.f, 0.f, 0.f, 0.f, 0.f, 0.f, 0.f, 0.f, 0.f}; O[1] = O[0];
            RD_UO(FA, 0); RD_UO(FB, 1); RD_UO(FC, 2); SCHED_FENCE();
            MM_UO(FA, 0); SCHED_FENCE(); RD_UO(FA, 3); SCHED_FENCE();
            MM_UO(FB, 1); SCHED_FENCE(); RD_UO(FB, 4); SCHED_FENCE();
            MM_UO(FC, 2); SCHED_FENCE(); RD_UO(FC, 5); SCHED_FENCE();
            MM_UO(FA, 3); SCHED_FENCE(); RD_UO(FA, 6); SCHED_FENCE();
            MM_UO(FB, 4); SCHED_FENCE(); RD_UO(FB, 7); SCHED_FENCE();
            MM_UO(FC, 5); SCHED_FENCE();
            MM_UO(FA, 6); SCHED_FENCE();
            FA[0] = RD_QK(0, 0); FA[1] = RD_QK(0, 1); FA[2] = RD_QK(1, 0); FA[3] = RD_QK(1, 1); SCHED_FENCE();
            MM_UO(FB, 7); SCHED_FENCE();
            FB[0] = RD_QK(2, 1); FB[1] = RD_QK(3, 1); FB[2] = RD_KT(0, 0); FB[3] = RD_KT(1, 0); SCHED_FENCE();
            bf16x8 Ub[4];
#pragma unroll
            for (int k = 0; k < 4; ++k) Ub[k] = pack_acc(U[k >> 1], k & 1);
            O[0] = MFMA32(FA[0], Ub[0], O[0]); O[1] = MFMA32(FA[1], Ub[0], O[1]); O[0] = MFMA32(FA[2], Ub[1], O[0]); O[1] = MFMA32(FA[3], Ub[1], O[1]); SCHED_FENCE();
            FA[0] = RD_KT(2, 0); FA[1] = RD_KT(3, 0); FA[2] = RD_KT(0, 1); FA[3] = RD_KT(1, 1); SCHED_FENCE();
            S[0] = S[0] * gt;
            O[1] = MFMA32(FB[0], Ub[2], O[1]); O[1] = MFMA32(FB[1], Ub[3], O[1]); S[0] = MFMA32(FB[2], Ub[0], S[0]); S[0] = MFMA32(FB[3], Ub[1], S[0]); SCHED_FENCE();
            FB[0] = RD_KT(2, 1); FB[1] = RD_KT(3, 1); FB[2] = RD_KT(0, 2); FB[3] = RD_KT(1, 2); SCHED_FENCE();
            S[1] = S[1] * gt;
            S[0] = MFMA32(FA[0], Ub[2], S[0]); S[0] = MFMA32(FA[1], Ub[3], S[0]); S[1] = MFMA32(FA[2], Ub[0], S[1]); S[1] = MFMA32(FA[3], Ub[1], S[1]); SCHED_FENCE();
            FA[0] = RD_KT(2, 2); FA[1] = RD_KT(3, 2); FA[2] = RD_KT(0, 3); FA[3] = RD_KT(1, 3); SCHED_FENCE();
            S[2] = S[2] * gt;
            S[1] = MFMA32(FB[0], Ub[2], S[1]); S[1] = MFMA32(FB[1], Ub[3], S[1]); S[2] = MFMA32(FB[2], Ub[0], S[2]); S[2] = MFMA32(FB[3], Ub[1], S[2]); SCHED_FENCE();
            FB[0] = RD_KT(2, 3); FB[1] = RD_KT(3, 3); SCHED_FENCE();
            S[3] = S[3] * gt;
            S[2] = MFMA32(FA[0], Ub[2], S[2]); S[2] = MFMA32(FA[1], Ub[3], S[2]); S[3] = MFMA32(FA[2], Ub[0], S[3]); S[3] = MFMA32(FA[3], Ub[1], S[3]); SCHED_FENCE();
#pragma unroll
            for (int mt = 0; mt < 2; ++mt)
#pragma unroll
                for (int e = 0; e < 16; ++e) { const int i = 32 * mt + (e & 3) + 8 * (e >> 2) + 4 * hh;
                    *(LAS bf16_t*)(lds + ob + i * 272 + (32 * w + r) * 2) = f2bf(O[mt][e]); }
            S[3] = MFMA32(FB[0], Ub[2], S[3]); S[3] = MFMA32(FB[1], Ub[3], S[3]);
#undef RD_UO
#undef MM_UO
#undef RD_WK
#undef RD_QD
#undef RD_QK
#undef RD_KT
#undef SCHED_FENCE
            BAR_LDS();
        }
#if SCAN_PRIO
        __builtin_amdgcn_s_setprio(0);
#endif
        if (MODE == 0) {
        float* so = P.out + O_PGDN + (size_t)gi * 128 * 128;
#pragma unroll
        for (int T = 0; T < 4; ++T)
#pragma unroll
            for (int e = 0; e < 16; ++e) so[(32 * T + (e & 3) + 8 * (e >> 2) + 4 * hh) * 128 + 32 * w + r] = S[T][e];
        } else { float acc_ = 0.f; for (int T = 0; T < 4; ++T) acc_ += S[T][0]; if (acc_ == 123.456f) P.out[0] = acc_; }
    } else {
        bf16_t* mix = (bf16_t*)(P.ws + WS_MIX);
        const int t2 = tid - 256; int i = t2 >> 2, qd = t2 & 3;
        unsigned lo16 = (unsigned)t2 * 16u;
        asm volatile("" : "+v"(lo16));
        u32x4 nxA[14], nxB[14], zA[4], zB[4];
#define LOADNX(X, c_) do { _Pragma("unroll") for (int k = 0; k < 14; ++k) X[k] = *(const u32x4*)(stg + (size_t)(c_) * GDNI_STG + k * 4096 + lo16); } while (0)
#define WRITENX(X, off_) do { _Pragma("unroll") for (int k = 0; k < 14; ++k) *(LAS u32x4*)(lds + (off_) + k * 4096 + lo16) = X[k]; } while (0)
#define LOADZ(Z, c_) do { const u32x4* zp_ = (const u32x4*)(P.ws + WS_ZS + (size_t)(ci0 + ((MODE & 8) ? ((c_) & 3) : (c_))) * 16384 + i * 256 + qd * 64); _Pragma("unroll") for (int k = 0; k < 4; ++k) Z[k] = zp_[k]; } while (0)
#define POST(Z, c_, ob_) do { \
            float ssq = 0.f; \
            _Pragma("unroll") for (int k = 0; k < 4; ++k) { const u32x4 ov = *(const LAS u32x4*)(lds + (ob_) + i * 272 + qd * 64 + k * 16); \
                const float a0 = bflo(ov.x), a1 = bfhi(ov.x), a2 = bflo(ov.y), a3 = bfhi(ov.y), a4 = bflo(ov.z), a5 = bfhi(ov.z), a6 = bflo(ov.w), a7 = bfhi(ov.w); \
                ssq += (a0 * a0 + a1 * a1) + (a2 * a2 + a3 * a3) + (a4 * a4 + a5 * a5) + (a6 * a6 + a7 * a7); } \
            ssq += __shfl_xor(ssq, 1); ssq += __shfl_xor(ssq, 2); \
            const float rstd = rsqrtf(ssq * (1.0f / 128.0f) + EPS); \
            u32x4* mp = (u32x4*)(mix + (size_t)(Rb + (c_) * 64 + i) * D + h * 128 + 32 * qd); \
            _Pragma("unroll") for (int k = 0; k < 4; ++k) { const u32x4 ov = *(const LAS u32x4*)(lds + (ob_) + i * 272 + qd * 64 + k * 16); \
                const float y0 = bflo(ov.x) * rstd * bflo(Z[k].x), y1 = bfhi(ov.x) * rstd * bfhi(Z[k].x); \
                const float y2 = bflo(ov.y) * rstd * bflo(Z[k].y), y3 = bfhi(ov.y) * rstd * bfhi(Z[k].y); \
                const float y4 = bflo(ov.z) * rstd * bflo(Z[k].z), y5 = bfhi(ov.z) * rstd * bfhi(Z[k].z); \
                const float y6 = bflo(ov.w) * rstd * bflo(Z[k].w), y7 = bfhi(ov.w) * rstd * bfhi(Z[k].w); \
                const u32x4 res_ = (u32x4){pk2(y0, y1), pk2(y2, y3), pk2(y4, y5), pk2(y6, y7)}; if (MODE == 0) mp[k] = res_; else if (res_.x == 0x12345678u && res_.y == 0x9abcdef0u) mp[k] = res_; asm volatile("" ::: "memory"); } } while (0)
        LOADNX(nxA, 0); LOADNX(nxB, 1);
        __builtin_amdgcn_sched_barrier(0);
        WRITENX(nxA, SC_STG0); WRITENX(nxB, SC_STG1);
        __builtin_amdgcn_sched_barrier(0);
        LOADZ(zA, 0); LOADZ(zB, 1); LOADNX(nxA, 2); LOADNX(nxB, 3);
        BAR_LDS();
        for (int n = 0; n < NCHUNK; n += 2) {
            asm volatile("" : "+v"(i), "+v"(qd), "+v"(lo16));
            BAR_LDS();
            if (!(MODE & 2)) { POST(zA, n, SC_OB0); }
            if (n + 2 < NCHUNK) { if (!(MODE & 2)) LOADZ(zA, n + 2); if (!(MODE & 4)) WRITENX(nxA, SC_STG0); }
            if (n + 4 < NCHUNK && !(MODE & 4)) LOADNX(nxA, n + 4);
            BAR_LDS();
            if (!(MODE & 2)) { POST(zB, n + 1, SC_OB1); }
            if (n + 3 < NCHUNK) { if (!(MODE & 2)) LOADZ(zB, n + 3); if (!(MODE & 4)) WRITENX(nxB, SC_STG1); }
            if (n + 5 < NCHUNK && !(MODE & 4)) LOADNX(nxB, n + 5);
        }
#undef LOADNX
#undef WRITENX
#undef LOADZ
#undef POST
        if (MODE == 0) for (int idx = t2; idx < 3 * 384; idx += 256) { const int j = idx / 384, c = idx % 384, col = (c >> 7) * 512 + h * 128 + (c & 127);
            P.out[O_PGDNCONV + ((size_t)b * 3 + j) * 1536 + col] = bf2f(proj[(size_t)(Rb + TSEQ - 3 + j) * NIN + col]); }
    }
}
constexpr int LR_CW = 0;
constexpr int LR_CAR = 2048;
constexpr int LR_WL = 10240, LR_WSZ = 9216, LR_WB = 84992;
DI void lru_block(const Params& P, LAS unsigned char* lds, int li) {
    int tid = threadIdx.x; asm volatile("" : "+v"(tid)); const int lane = tid & 63, wave = __builtin_amdgcn_readfirstlane(tid >> 6);
    const int nb = li & 7, b = li >> 3, Rb = b * TSEQ;
    const bf16_t* proj = (const bf16_t*)(P.ws + WS_BIG);
    bf16_t* mix = (bf16_t*)(P.ws + WS_MIX);
    const int fr = lane & 15, fq = lane >> 4;
    LAS float* CW = (LAS float*)(lds + LR_CW);
    LAS float* XT = (LAS float*)(lds + LR_WL + wave * LR_WSZ);
    LAS bf16_t* GT = (LAS bf16_t*)(lds + LR_WL + wave * LR_WSZ + 4352);
    LAS bf16_t* YT = (LAS bf16_t*)(lds + LR_WL + wave * LR_WSZ + 6656);
    if (tid < 256) CW[tid] = P.in[I_CONVL][(tid >> 6) * 512 + nb * 64 + (tid & 63)]; else if (tid < 320) CW[tid] = P.in[I_CONVLB][nb * 64 + (tid - 256)];
    float cba[4], cbx[4], csp[4];
#pragma unroll
    for (int ct = 0; ct < 4; ++ct) { const int oc = 16 * ct + fr;
        cba[ct] = P.in[I_LBA][nb * 64 + oc]; cbx[ct] = P.in[I_LBX][nb * 64 + oc]; csp[ct] = 8.0f * softplusf_(-P.in[I_LLAM][nb * 64 + oc]); }
    { const int gsel = wave >> 2, ct = wave & 3, oc = 16 * ct + fr; const float* W = P.in[gsel ? I_LWX : I_LWA] + (size_t)nb * 4096;
#pragma unroll
      for (int ks = 0; ks < 2; ++ks) { unsigned pw[4];
#pragma unroll
          for (int j = 0; j < 4; ++j) { const int i0 = 32 * ks + 8 * fq + 2 * j; pw[j] = pk2(W[i0 * 64 + oc], W[(i0 + 1) * 64 + oc]); }
          *(LAS u32x4*)(lds + LR_WB + (((gsel * 4 + ct) * 2 + ks) * 64 + lane) * 16) = (u32x4){pw[0], pw[1], pw[2], pw[3]}; } }
    float hb[4] = {0.f, 0.f, 0.f, 0.f};
    u32x4 xin[4][2], gin[2];
#define LR_LOAD(it_) do { const int tb_ = (it_) * 128 + 16 * wave; \
        _Pragma("unroll") for (int j = 0; j < 4; ++j) { const int t = tb_ + fr + j - 3; \
            _Pragma("unroll") for (int ks = 0; ks < 2; ++ks) { xin[j][ks] = (u32x4){0u, 0u, 0u, 0u}; \
                if (t >= 0) xin[j][ks] = *(const u32x4*)(proj + (size_t)(Rb + t) * NIN + 2560 + nb * 64 + 32 * ks + 8 * fq); } } \
        _Pragma("unroll") for (int k = 0; k < 2; ++k) { const int p_ = lane + 64 * k; gin[k] = *(const u32x4*)(proj + (size_t)(Rb + tb_ + (p_ >> 3)) * NIN + 2048 + nb * 64 + 8 * (p_ & 7)); } } while (0)
    LR_LOAD(0);
    __syncthreads();
    for (int it = 0; it < TSEQ / 128; ++it) {
        const int tb = it * 128 + 16 * wave, par = it & 1;
        float xr[2][8];
#pragma unroll
        for (int ks = 0; ks < 2; ++ks) {
            const LAS float* cwp = CW + 32 * ks + 8 * fq;
            const f32x4 b0 = *(const LAS f32x4*)(cwp + 256), b1 = *(const LAS f32x4*)(cwp + 260);
            float acc8[8] = {b0[0], b0[1], b0[2], b0[3], b1[0], b1[1], b1[2], b1[3]};
#pragma unroll
            for (int j = 0; j < 4; ++j) { const f32x4 w0 = *(const LAS f32x4*)(cwp + 64 * j), w1 = *(const LAS f32x4*)(cwp + 64 * j + 4); const u32x4 x = xin[j][ks];
                acc8[0] += w0[0] * bflo(x.x); acc8[1] += w0[1] * bfhi(x.x); acc8[2] += w0[2] * bflo(x.y); acc8[3] += w0[3] * bfhi(x.y);
                acc8[4] += w1[0] * bflo(x.z); acc8[5] += w1[1] * bfhi(x.z); acc8[6] += w1[2] * bflo(x.w); acc8[7] += w1[3] * bfhi(x.w); }
#pragma unroll
            for (int e = 0; e < 8; ++e) xr[ks][e] = acc8[e];
        }
        const u32x4 g0 = gin[0], g1 = gin[1];
        if (it + 1 < TSEQ / 128) LR_LOAD(it + 1);
#pragma unroll
        for (int ks = 0; ks < 2; ++ks) { LAS float* d = XT + fr * 68 + 32 * ks + 8 * fq;
            *(LAS f32x4*)d = (f32x4){xr[ks][0], xr[ks][1], xr[ks][2], xr[ks][3]}; *(LAS f32x4*)(d + 4) = (f32x4){xr[ks][4], xr[ks][5], xr[ks][6], xr[ks][7]}; }
        *(LAS u32x4*)(GT + (lane >> 3) * 72 + 8 * (lane & 7)) = g0; *(LAS u32x4*)(GT + (8 + (lane >> 3)) * 72 + 8 * (lane & 7)) = g1;
        bf16x8 af[2];
#pragma unroll
        for (int ks = 0; ks < 2; ++ks) af[ks] = __builtin_bit_cast(bf16x8, (u32x4){pk2(xr[ks][0], xr[ks][1]), pk2(xr[ks][2], xr[ks][3]), pk2(xr[ks][4], xr[ks][5]), pk2(xr[ks][6], xr[ks][7])});
        f32x4 ra[4], ia[4];
#pragma unroll
        for (int ct = 0; ct < 4; ++ct) { ra[ct] = (f32x4){0.f, 0.f, 0.f, 0.f}; ia[ct] = ra[ct];
#pragma unroll
            for (int ks = 0; ks < 2; ++ks) { const bf16x8 wa_ = *(const LAS bf16x8*)(lds + LR_WB + (((0 * 4 + ct) * 2 + ks) * 64 + lane) * 16), wx_ = *(const LAS bf16x8*)(lds + LR_WB + (((1 * 4 + ct) * 2 + ks) * 64 + lane) * 16);
                ra[ct] = __builtin_amdgcn_mfma_f32_16x16x32_bf16(af[ks], wa_, ra[ct], 0, 0, 0); ia[ct] = __builtin_amdgcn_mfma_f32_16x16x32_bf16(af[ks], wx_, ia[ct], 0, 0, 0); } }
        asm volatile("s_waitcnt lgkmcnt(0)" ::: "memory");
        float hl[4][4], pl[4][4], Ae[4], Be[4];
#pragma unroll
        for (int ct = 0; ct < 4; ++ct) {
            float h = 0.f, pr = 1.f;
#pragma unroll
            for (int r = 0; r < 4; ++r) {
                const float rg = sigmoidf_(ra[ct][r] + cba[ct]), ig = sigmoidf_(ia[ct][r] + cbx[ct]);
                const float a = __expf(-rg * csp[ct]);
                const float bco = __builtin_amdgcn_sqrtf(fmaxf(fmaf(-a, a, 1.0f), 0.f)) * ig * XT[(4 * fq + r) * 68 + 16 * ct + fr];
                h = a * h + bco; pr = pr * a; hl[ct][r] = h; pl[ct][r] = pr;
            }
            float A = pr, B = h;
            { const float pa = __shfl_up(A, 16), pb = __shfl_up(B, 16); if (fq >= 1) { B = A * pb + B; A = A * pa; } }
            { const float pa = __shfl_up(A, 32), pb = __shfl_up(B, 32); if (fq >= 2) { B = A * pb + B; A = A * pa; } }
            const float ea = __shfl_up(A, 16), eb = __shfl_up(B, 16);
            Ae[ct] = (fq >= 1) ? ea : 1.f; Be[ct] = (fq >= 1) ? eb : 0.f;
            if (fq == 3) { LAS float* c = (LAS float*)(lds + LR_CAR) + ((par * 8 + wave) * 2) * 64 + 16 * ct + fr; c[0] = A; c[64] = B; }
        }
        BAR_LDS();
        float hin[4];
#pragma unroll
        for (int ct = 0; ct < 4; ++ct) {
            float h = hb[ct]; hin[ct] = h;
#pragma unroll
            for (int v = 0; v < 8; ++v) { const LAS float* c = (const LAS float*)(lds + LR_CAR) + ((par * 8 + v) * 2) * 64 + 16 * ct + fr;
                h = c[0] * h + c[64]; if (v + 1 == wave) hin[ct] = h; }
            hb[ct] = h;
        }
#pragma unroll
        for (int ct = 0; ct < 4; ++ct)
#pragma unroll
            for (int r = 0; r < 4; ++r) {
                const float hw = hl[ct][r] + pl[ct][r] * Be[ct], pw = pl[ct][r] * Ae[ct];
                const float hfin = hw + pw * hin[ct];
                const float g = bf2f(GT[(4 * fq + r) * 72 + 16 * ct + fr]);
                YT[(4 * fq + r) * 72 + 16 * ct + fr] = f2bf(gelu_tanh(g) * hfin);
            }
        asm volatile("s_waitcnt lgkmcnt(0)" ::: "memory");
#pragma unroll
        for (int k = 0; k < 2; ++k) { const int p_ = lane + 64 * k;
            *(u32x4*)(mix + (size_t)(Rb + tb + (p_ >> 3)) * D + 512 + nb * 64 + 8 * (p_ & 7)) = *(const LAS u32x4*)(YT + (p_ >> 3) * 72 + 8 * (p_ & 7)); }
    }
#undef LR_LOAD
    if (wave == 0 && fq == 0) {
#pragma unroll
        for (int ct = 0; ct < 4; ++ct) P.out[O_PLRU + (size_t)b * 512 + nb * 64 + 16 * ct + fr] = hb[ct];
    }
    if (tid < 192) { const int j = tid >> 6, c = tid & 63; P.out[O_PLRUCONV + ((size_t)b * 3 + j) * 512 + nb * 64 + c] = bf2f(proj[(size_t)(Rb + TSEQ - 3 + j) * NIN + 2560 + nb * 64 + c]); }
}

DI void sample_ab_block(const Params& P, LAS unsigned char* lds, int sb) {
    int tid = threadIdx.x; asm volatile("" : "+v"(tid)); const int lane = tid & 63, wave = __builtin_amdgcn_readfirstlane(tid >> 6);
    const bf16_t* proj = (const bf16_t*)(P.ws + WS_BIG);
    bf16_t* mix = (bf16_t*)(P.ws + WS_MIX);
    LAS float* xr = (LAS float*)lds;
    {
        const int c = tid;
        const float* cw = P.in[I_CONVL];
        const float w0 = cw[c], w1 = cw[512 + c], w2 = cw[1024 + c], w3 = cw[1536 + c], cb = P.in[I_CONVLB][c];
#pragma unroll
        for (int k = 0; k < 2; ++k) {
            const int s = 2 * sb + k, r = MP + s;
            const float* buf = P.in[I_SLRUCONV] + (size_t)s * 3 * 512;
            const float xn = bf2f(proj[(size_t)r * NIN + 2560 + c]);
            const float b0 = buf[c], b1 = buf[512 + c], b2 = buf[1024 + c];
            xr[k * 512 + c] = w0 * b0 + w1 * b1 + w2 * b2 + w3 * xn + cb;
            float* co = P.out + O_SLRUCONV + (size_t)s * 3 * 512;
            co[c] = b1; co[512 + c] = b2; co[1024 + c] = xn;
        }
        __syncthreads();
        const int nb = c >> 6, oc = c & 63;
        const float* wa = P.in[I_LWA] + (size_t)nb * 4096 + oc; const float* wx = P.in[I_LWX] + (size_t)nb * 4096 + oc;
        float ra0 = P.in[I_LBA][c], ia0 = P.in[I_LBX][c], ra1 = ra0, ia1 = ia0;
#pragma unroll 1
        for (int i0 = 0; i0 < 64; i0 += 32) {
            float va[32], vx[32];
#pragma unroll
            for (int i = 0; i < 32; ++i) { va[i] = wa[(i0 + i) * 64]; vx[i] = wx[(i0 + i) * 64]; }
            __builtin_amdgcn_sched_barrier(0);
#pragma unroll
            for (int i = 0; i < 32; ++i) { const float x0 = xr[nb * 64 + i0 + i], x1 = xr[512 + nb * 64 + i0 + i];
                ra0 += x0 * va[i]; ia0 += x0 * vx[i]; ra1 += x1 * va[i]; ia1 += x1 * vx[i]; }
        }
        const float sp = softplusf_(-P.in[I_LLAM][c]);
#pragma unroll
        for (int k = 0; k < 2; ++k) {
            const int s = 2 * sb + k, r = MP + s;
            const float rg = sigmoidf_(k ? ra1 : ra0), ig = sigmoidf_(k ? ia1 : ia0);
            const float la = -8.0f * rg * sp;
            const float a = __expf(la), bb = sqrtf(-expm1f(2.0f * la)) * ig * xr[k * 512 + c];
            const float hnew = a * P.in[I_SLRU][(size_t)s * 512 + c] + bb;
            P.out[O_SLRU + (size_t)s * 512 + c] = hnew;
            mix[(size_t)r * D + 512 + c] = f2bf(gelu_tanh(bf2f(proj[(size_t)r * NIN + 2048 + c])) * hnew);
        }
    }
    __syncthreads();
    {
        const int k = wave >> 2, h = wave & 3, s = 2 * sb + k, r = MP + s;
        LAS float* qk = (LAS float*)(lds + 4096) + wave * 256;
        const float* buf = P.in[I_SGDNCONV] + (size_t)s * 3 * 1536; const float* cw = P.in[I_CONVG];
        float* co = P.out + O_SGDNCONV + (size_t)s * 3 * 1536;
        float val[3][2];
#pragma unroll
        for (int wh = 0; wh < 3; ++wh)
#pragma unroll
            for (int p = 0; p < 2; ++p) { const int col = wh * 512 + h * 128 + 64 * p + lane;
                const float xn = bf2f(proj[(size_t)r * NIN + col]);
                const float b0 = buf[col], b1 = buf[1536 + col], b2 = buf[3072 + col];
                val[wh][p] = siluf_(cw[col] * b0 + cw[1536 + col] * b1 + cw[3072 + col] * b2 + cw[4608 + col] * xn);
                co[col] = b1; co[1536 + col] = b2; co[3072 + col] = xn; }
        const float ssq = wave_sum(val[0][0] * val[0][0] + val[0][1] * val[0][1]), ssk = wave_sum(val[1][0] * val[1][0] + val[1][1] * val[1][1]);
        const float rq = rsqrtf(ssq + EPS) * 0.08838834764831845f, rk = rsqrtf(ssk + EPS);
        qk[lane] = val[0][0] * rq; qk[64 + lane] = val[0][1] * rq; qk[128 + lane] = val[1][0] * rk; qk[192 + lane] = val[1][1] * rk;
        const float* BA = (const float*)(P.ws + WS_BA) + (size_t)r * 8;
        const float beta = sigmoidf_(BA[h]);
        const float eg = __expf(-__expf(P.in[I_ALOG][h]) * softplusf_(BA[4 + h] + P.in[I_DTB][h]));
        asm volatile("s_waitcnt lgkmcnt(0)" ::: "memory");
        const float* S0 = P.in[I_SGDN] + ((size_t)s * 4 + h) * 16384; float* S1 = P.out + O_SGDN + ((size_t)s * 4 + h) * 16384;
        float pr0 = 0.f, pr1 = 0.f, qs0 = 0.f, qs1 = 0.f;
#pragma unroll 1
        for (int d0 = 0; d0 < 128; d0 += 32) {
            const float* sp = S0 + (size_t)d0 * 128 + lane;
            float a[32], bq[32];
#pragma unroll
            for (int d = 0; d < 32; ++d) { a[d] = sp[d * 128]; bq[d] = sp[d * 128 + 64]; }
#pragma unroll
            for (int d = 0; d < 32; ++d) { const float kd = qk[128 + d0 + d], qd_ = qk[d0 + d]; pr0 += kd * a[d]; pr1 += kd * bq[d]; qs0 += qd_ * a[d]; qs1 += qd_ * bq[d]; }
        }
        const float qkdot = wave_sum(qk[lane] * qk[128 + lane] + qk[64 + lane] * qk[192 + lane]);
        const float dv0 = beta * (val[2][0] - eg * pr0), dv1 = beta * (val[2][1] - eg * pr1);
        const float o0 = eg * qs0 + qkdot * dv0, o1 = eg * qs1 + qkdot * dv1;
#pragma unroll 1
        for (int d0 = 0; d0 < 128; d0 += 32) {
            const float* sp = S0 + (size_t)d0 * 128 + lane; float* dp = S1 + (size_t)d0 * 128 + lane;
            float a[32], bq[32];
#pragma unroll
            for (int d = 0; d < 32; ++d) { a[d] = sp[d * 128]; bq[d] = sp[d * 128 + 64]; }
#pragma unroll
            for (int d = 0; d < 32; ++d) { const float kd = qk[128 + d0 + d]; dp[d * 128] = a[d] * eg + kd * dv0; dp[d * 128 + 64] = bq[d] * eg + kd * dv1; }
        }
        const float rstd = rsqrtf(wave_sum(o0 * o0 + o1 * o1) * (1.0f / 128.0f) + EPS);
#pragma unroll
        for (int p = 0; p < 2; ++p) { const int e = 64 * p + lane;
            const float z = bf2f(proj[(size_t)r * NIN + 1536 + h * 128 + e]);
            mix[(size_t)r * D + h * 128 + e] = f2bf((p ? o1 : o0) * rstd * P.in[I_GNW][e] * siluf_(z)); }
    }
    {
        const f32x4* ck = (const f32x4*)P.in[I_CK]; const f32x4* cv = (const f32x4*)P.in[I_CV];
        f32x4* ok = (f32x4*)(P.out + O_SSWAK); f32x4* ov = (f32x4*)(P.out + O_SSWAV);
        for (int pb = tid; pb < 4 * 8128; pb += 8 * 512) {
            f32x4 tmp[8];
#pragma unroll
            for (int j = 0; j < 8; ++j) { const int pc = pb + 512 * j; if (pc < 4 * 8128) { const int sel = pc / 8128, w = pc - sel * 8128, smp = 2 * sb + (sel & 1);
                tmp[j] = ((sel >> 1) ? cv : ck)[smp * 8192 + 64 + w]; } }
            __builtin_amdgcn_sched_barrier(0);
#pragma unroll
            for (int j = 0; j < 8; ++j) { const int pc = pb + 512 * j; if (pc < 4 * 8128) { const int sel = pc / 8128, w = pc - sel * 8128, smp = 2 * sb + (sel & 1);
                ((sel >> 1) ? ov : ok)[smp * 8192 + w] = tmp[j]; } }
        }
    }
}
#ifndef AT_KVREP
#define AT_KVREP 1
#endif
constexpr int AT_K = 0, AT_V = 32768, AT_O = 65536, AT_ORS = 136;
typedef short s16x4 __attribute__((ext_vector_type(4)));
DI int at_vst(int k, int c) { const int kk = (k & ~0xC) | ((k & 4) << 1) | ((k & 8) >> 1); return ((kk >> 3) * 2 + (c >> 5)) * 512 + ((kk & 7) * 32 + (c & 31)) * 2; }
DI float max3_(float a, float b, float c) { float d; asm("v_max3_f32 %0, %1, %2, %3" : "=v"(d) : "v"(a), "v"(b), "v"(c)); return d; }
DI float alibi_slope(int hq) { return exp2f(-0.5f * (float)(hq + 1)); }
template <int MODE>
DI void attn_prompt_run(const Params& P, LAS unsigned char* lds, int first, int cnt) {
    int tid0 = threadIdx.x; asm volatile("" : "+v"(tid0)); const int wave = __builtin_amdgcn_readfirstlane(tid0 >> 6);
    const bf16_t* qkv = (const bf16_t*)(P.ws + WS_BIG);
    bf16_t* att = (bf16_t*)(P.ws + WS_MIX);
    u32x4 kraw[4], vraw[4];
#define AT_LOADKV(it_) do { const int kvh_ = (it_) & 3, qb_ = ((it_) >> 2) & 15, b_ = (it_) >> 6, Rq_ = b_ * TSEQ + qb_ * 128; \
        _Pragma("unroll") for (int rep = 0; rep < 4; ++rep) { const int idx = tid0 + 512 * rep; \
            { const int row = idx >> 3, ch = idx & 7; kraw[rep] = (u32x4){0u, 0u, 0u, 0u}; \
              if (qb_ > 0 || row >= 128) kraw[rep] = *(const u32x4*)(qkv + (size_t)(Rq_ - 128 + row) * NQKV + 1024 + kvh_ * 64 + 8 * ch); \
              vraw[rep] = (u32x4){0u, 0u, 0u, 0u}; \
              if (qb_ > 0 || row >= 128) vraw[rep] = *(const u32x4*)(qkv + (size_t)(Rq_ - 128 + row) * NQKV + 1280 + kvh_ * 64 + 8 * ch); } } } while (0)
    bf16x8 qf[2][4];
#define AT_LOADQ(rep_, it_) do { const int kvh_ = (it_) & 3, qb_ = ((it_) >> 2) & 15, b_ = (it_) >> 6, Rq_ = b_ * TSEQ + qb_ * 128, wi_ = wave + 8 * (rep_), ln_ = tid0 & 63; \
        _Pragma("unroll") for (int ks = 0; ks < 4; ++ks) qf[rep_][ks] = *(const bf16x8*)(qkv + (size_t)(Rq_ + 32 * (wi_ & 3) + (ln_ & 31)) * NQKV + (kvh_ * 4 + (wi_ >> 2)) * 64 + 16 * ks + 8 * (ln_ >> 5)); } while (0)
    if (cnt > 0) { AT_LOADKV(first); AT_LOADQ(0, first); AT_LOADQ(1, first); }
    LAS float* sinks_l = (LAS float*)(lds + AT_O + 8 * 32 * AT_ORS);
    if (tid0 < 16) sinks_l[tid0] = P.in[I_SINKS][tid0];
    for (int kk = 0; kk < cnt; ++kk) {
        const int it = first + kk;
        int tid = tid0; asm volatile("" : "+v"(tid));
        const int lane = tid & 63;
        const int kvh = it & 3, qb = (it >> 2) & 15, b = it >> 6;
        const int Rq = b * TSEQ + qb * 128;
        BAR_LDS();
#pragma unroll
        for (int rep = 0; rep < 4; ++rep) {
            const int idx = tid + 512 * rep;
            { const int row = idx >> 3, ch = idx & 7; *(LAS u32x4*)(lds + AT_K + img128(row, ch)) = kraw[rep]; *(LAS u32x4*)(lds + AT_V + at_vst(row, 8 * ch)) = vraw[rep]; }
        }
        const int r = lane & 31, hh = lane >> 5;
        BAR_LDS();
#pragma unroll
        for (int rep = 0; rep < (MODE == 1 ? 0 : 2); ++rep) {
            const int wi = wave + 8 * rep, g = wi >> 2, q0 = 32 * (wi & 3), hq = kvh * 4 + g;
            const float L2E = 1.4426950408889634f;
            const float slope = alibi_slope(hq) * L2E, sink = sinks_l[hq] * L2E;
            const int ktmin = (qb > 0) ? 0 : 4 - (wi & 3);
            f32x16 sc[5];
#pragma unroll
            for (int kt = 0; kt < 5; ++kt) {
                f32x16 a = {0.f, 0.f, 0.f, 0.f, 0.f, 0.f, 0.f, 0.f, 0.f, 0.f, 0.f, 0.f, 0.f, 0.f, 0.f, 0.f};
#pragma unroll
                for (int ks = 0; ks < 4; ++ks) { const bf16x8 kf = *(const LAS bf16x8*)(lds + AT_K + img128(q0 + 32 * kt + r, 2 * ks + hh)); a = MFMA32(kf, qf[rep][ks], a); }
                sc[kt] = a;
            }
            if (kk + 1 < cnt) { AT_LOADQ(rep, it + 1); if (rep == AT_KVREP) AT_LOADKV(it + 1); }
            float m = sink; f32x2 sum2 = {0.f, 0.f};
            if (MODE != 3) {
            const float tl = slope * (float)(4 * hh - 128 - r);
            const int dl = r - 4 * hh;
            const f32x2 C2 = {0.125f * L2E, 0.125f * L2E};
            f32x2 bias2[8];
#pragma unroll
            for (int e2 = 0; e2 < 8; ++e2) { const int rowc = ((2 * e2) & 3) + 8 * ((2 * e2) >> 2); bias2[e2] = (f32x2){tl + slope * (float)rowc, tl + slope * (float)(rowc + 1)}; }
#pragma unroll
            for (int kt = 0; kt < 5; ++kt) {
                float mt = -1e30f;
#pragma unroll
                for (int e2 = 0; e2 < 8; ++e2) { const int e0 = 2 * e2, rowc = (e0 & 3) + 8 * (e0 >> 2);
                    f32x2 sv = (f32x2){sc[kt][e0], sc[kt][e0 + 1]} * C2 + bias2[e2];
                    if (kt == 0) { sv.x = (rowc < dl) ? -1e30f : sv.x; sv.y = (rowc + 1 < dl) ? -1e30f : sv.y; }
                    if (kt == 4) { sv.x = (rowc > dl) ? -1e30f : sv.x; sv.y = (rowc + 1 > dl) ? -1e30f : sv.y; }
                    sc[kt][e0] = sv.x; sc[kt][e0 + 1] = sv.y; mt = max3_(mt, sv.x, sv.y); }
                mt += slope * (float)(32 * kt);
                m = fmaxf(m, (kt >= ktmin) ? mt : -1e30f);
            }
            m = fmaxf(m, __shfl_xor(m, 32));
#pragma unroll
            for (int kt = 0; kt < 5; ++kt) {
                const float ck = (kt >= ktmin) ? slope * (float)(32 * kt) - m : -1e30f;
                const f32x2 ck2 = {ck, ck};
#pragma unroll
                for (int e2 = 0; e2 < 8; ++e2) { f32x2 p = (f32x2){sc[kt][2 * e2], sc[kt][2 * e2 + 1]} + ck2;
                    p.x = __builtin_amdgcn_exp2f(p.x); p.y = __builtin_amdgcn_exp2f(p.y);
                    sc[kt][2 * e2] = p.x; sc[kt][2 * e2 + 1] = p.y; sum2 += p; }
            }
            }
            float sum = sum2.x + sum2.y;
            sum += __shfl_xor(sum, 32);
            const float inv = __builtin_amdgcn_rcpf(sum + __builtin_amdgcn_exp2f(sink - m));
            f32x16 O[2];
#pragma unroll
            for (int dt = 0; dt < 2; ++dt) O[dt] = (f32x16){0.f, 0.f, 0.f, 0.f, 0.f, 0.f, 0.f, 0.f, 0.f, 0.f, 0.f, 0.f, 0.f, 0.f, 0.f, 0.f};
            const LAS unsigned char* vb0 = lds + AT_V + q0 * 128 + hh * 1024 + ((lane >> 2) & 3) * 64 + ((lane >> 4) & 1) * 32 + (lane & 3) * 8;
#pragma unroll
            for (int kt = 0; kt < 5; ++kt) {
#pragma unroll
                for (int s2 = 0; s2 < 2; ++s2) {
                    const bf16x8 pa = pack_acc(sc[kt], s2);
#pragma unroll
                    for (int dt = 0; dt < 2; ++dt) {
                        const LAS unsigned char* vp = vb0 + (32 * kt + 16 * s2) * 128 + dt * 512;
                        const s16x4 lo = __builtin_amdgcn_ds_read_tr16_b64_v4i16((LAS s16x4*)vp), hi = __builtin_amdgcn_ds_read_tr16_b64_v4i16((LAS s16x4*)(vp + 256));
                        const bf16x8 vb = __builtin_bit_cast(bf16x8, (short __attribute__((ext_vector_type(8)))){lo[0], lo[1], lo[2], lo[3], hi[0], hi[1], hi[2], hi[3]});
                        O[dt] = MFMA32(vb, pa, O[dt]);
                    }
                }
            }
            LAS unsigned char* ot = lds + AT_O + wave * (32 * AT_ORS);
#pragma unroll
            for (int dt = 0; dt < 2; ++dt)
#pragma unroll
                for (int g4 = 0; g4 < 4; ++g4) {
                    const u32x2 w = {pk2(O[dt][4 * g4] * inv, O[dt][4 * g4 + 1] * inv), pk2(O[dt][4 * g4 + 2] * inv, O[dt][4 * g4 + 3] * inv)};
                    *(LAS u32x2*)(ot + r * AT_ORS + (32 * dt + 8 * g4 + 4 * hh) * 2) = w;
                }
#pragma unroll
            for (int i = 0; i < 4; ++i) { const int row = 8 * i + (lane >> 3), ch = lane & 7;
                const u32x4 w = *(const LAS u32x4*)(ot + row * AT_ORS + ch * 16);
                if (MODE != 2 || w.x == 0x12345679u) *(u32x4*)(att + (size_t)(Rq + q0 + row) * D + hq * 64 + 8 * ch) = w; }
            asm volatile("" ::: "memory");
        }
        if (qb == 15) {
            for (int idx = tid; idx < 128 * 64; idx += 512) { const int j = idx >> 6, d = idx & 63;
                const bf16_t kv = *(const LAS bf16_t*)(lds + AT_K + img128(128 + j, d >> 3) + (d & 7) * 2);
                const bf16_t vv = *(const LAS bf16_t*)(lds + AT_V + at_vst(128 + j, d));
                P.out[O_PSWAK + (((size_t)b * 128 + j) * 4 + kvh) * 64 + d] = bf2f(kv);
                P.out[O_PSWAV + (((size_t)b * 128 + j) * 4 + kvh) * 64 + d] = bf2f(vv); }
        }
    }
#undef AT_LOADKV
#undef AT_LOADQ
}

DI void attn_sample_item(const Params& P, LAS unsigned char* lds, int s) {
    int tid = threadIdx.x; asm volatile("" : "+v"(tid));
    const int r = MP + s;
    const bf16_t* qkv = (const bf16_t*)(P.ws + WS_BIG);
    bf16_t* att = (bf16_t*)(P.ws + WS_MIX);
    LAS float* qs = (LAS float*)lds;
    LAS float* kn = qs + 1024;
    LAS float* vn = kn + 256;
    LAS float* pp = vn + 256;
    LAS float* invs = pp + 16 * 132;
    LAS float* part = invs + 64;
    __syncthreads();
    { const int hq = tid >> 5, sub = tid & 31;
      const unsigned w = *(const unsigned*)(qkv + (size_t)r * NQKV + hq * 64 + 2 * sub); qs[hq * 64 + 2 * sub] = bflo(w); qs[hq * 64 + 2 * sub + 1] = bfhi(w); }
    if (tid < 256) kn[tid] = bf2f(qkv[(size_t)r * NQKV + 1024 + tid]); else vn[tid - 256] = bf2f(qkv[(size_t)r * NQKV + 1280 + (tid - 256)]);
    {
        const int kvh = tid >> 7, j = tid & 127;
        const f32x4* kr = (const f32x4*)(P.in[I_CK] + (size_t)s * 128 * 256 + (size_t)j * 256 + kvh * 64);
        f32x4 kv[16];
#pragma unroll
        for (int c = 0; c < 16; ++c) kv[c] = kr[c];
        __syncthreads();
        float d4[4] = {0.f, 0.f, 0.f, 0.f};
#pragma unroll
        for (int c = 0; c < 16; ++c)
#pragma unroll
            for (int g = 0; g < 4; ++g) { const f32x4 qv = *(const LAS f32x4*)(qs + (4 * kvh + g) * 64 + 4 * c); d4[g] += (kv[c][0] * qv[0] + kv[c][1] * qv[1]) + (kv[c][2] * qv[2] + kv[c][3] * qv[3]); }
#pragma unroll
        for (int g = 0; g < 4; ++g) pp[(4 * kvh + g) * 132 + j] = d4[g] * 0.125f - alibi_slope(4 * kvh + g) * (float)(128 - j);
        if (tid < 16) { float acc = 0.f;
#pragma unroll
            for (int c = 0; c < 64; ++c) acc += kn[(tid >> 2) * 64 + c] * qs[tid * 64 + c];
            pp[tid * 132 + 128] = acc * 0.125f; }
    }
    __syncthreads();
    { const int hq = tid >> 5, sub = tid & 31;
      const float sink = P.in[I_SINKS][hq];
      float sv[4]; float m = sink;
#pragma unroll
      for (int mm = 0; mm < 4; ++mm) { sv[mm] = pp[hq * 132 + sub + 32 * mm]; m = fmaxf(m, sv[mm]); }
      const float snew = pp[hq * 132 + 128]; m = fmaxf(m, snew);
#pragma unroll
      for (int o = 1; o < 32; o <<= 1) m = fmaxf(m, __shfl_xor(m, o));
      float sum = 0.f;
#pragma unroll
      for (int mm = 0; mm < 4; ++mm) { const float p = __expf(sv[mm] - m); pp[hq * 132 + sub + 32 * mm] = p; sum += p; }
#pragma unroll
      for (int o = 1; o < 32; o <<= 1) sum += __shfl_xor(sum, o);
      const float pnew = __expf(snew - m);
      if (sub == 0) { pp[hq * 132 + 128] = pnew; invs[hq] = __builtin_amdgcn_rcpf(sum + pnew + __expf(sink - m)); } }
    __syncthreads();
    { const int kvh = tid >> 7, jh = (tid >> 6) & 1, d = tid & 63;
      const float* cvp = P.in[I_CV] + (size_t)s * 128 * 256 + (size_t)(64 * jh) * 256 + kvh * 64 + d;
      float a4[4] = {0.f, 0.f, 0.f, 0.f};
#pragma unroll 1
      for (int jb = 0; jb < 64; jb += 32) {
          float v[32];
#pragma unroll
          for (int i = 0; i < 32; ++i) v[i] = cvp[(size_t)(jb + i) * 256];
          __builtin_amdgcn_sched_barrier(0);
#pragma unroll
          for (int i = 0; i < 32; ++i)
#pragma unroll
              for (int g = 0; g < 4; ++g) a4[g] += pp[(4 * kvh + g) * 132 + 64 * jh + jb + i] * v[i];
      }
#pragma unroll
      for (int g = 0; g < 4; ++g) part[(jh * 16 + 4 * kvh + g) * 64 + d] = a4[g]; }
    __syncthreads();
    { const int hq = tid >> 5, sub = tid & 31, kvh = hq >> 2;
      const float inv = invs[hq], pnew = pp[hq * 132 + 128];
      const float o0 = part[hq * 64 + 2 * sub] + part[(16 + hq) * 64 + 2 * sub] + pnew * vn[kvh * 64 + 2 * sub];
      const float o1 = part[hq * 64 + 2 * sub + 1] + part[(16 + hq) * 64 + 2 * sub + 1] + pnew * vn[kvh * 64 + 2 * sub + 1];
      *(unsigned*)(att + (size_t)r * D + hq * 64 + 2 * sub) = pk2(o0 * inv, o1 * inv); }
    float* ok = P.out + O_SSWAK + (size_t)s * 128 * 256; float* ov = P.out + O_SSWAV + (size_t)s * 128 * 256;
    if (tid < 256) ok[127 * 256 + tid] = kn[tid]; else ov[127 * 256 + (tid - 256)] = vn[tid - 256];
}

template <int DRY>
DI void final_norm(const Params& P, int vcu, int G, int m0) {
    int tid = threadIdx.x; asm volatile("" : "+v"(tid)); const int lane = tid & 63, wave = tid >> 6;
    const float* ss4 = (const float*)(P.ws + WS_SS) + 4 * (size_t)MPAD; const float* w = P.in[I_NFIN];
    const bf16_t* XB = (const bf16_t*)(P.ws + WS_XB);
    f32x4 wv[4];
#pragma unroll
    for (int j = 0; j < 4; ++j) wv[j] = *((const f32x4*)w + 2 * lane + 128 * (j >> 1) + (j & 1));
    for (int m = m0 + vcu * 8 + wave; m < MREAL; m += G * 8) {
        const float rs = rsqrtf(ss4[m] * (1.0f / 1024.0f) + EPS);
        const u32x4 a = *((const u32x4*)(XB + (size_t)m * D) + lane), b = *((const u32x4*)(XB + (size_t)m * D) + 64 + lane);
        f32x4* row = (f32x4*)(P.out + (size_t)m * D);
        const f32x4 o0 = (f32x4){bflo(a.x), bfhi(a.x), bflo(a.y), bfhi(a.y)} * rs * wv[0], o1 = (f32x4){bflo(a.z), bfhi(a.z), bflo(a.w), bfhi(a.w)} * rs * wv[1];
        const f32x4 o2 = (f32x4){bflo(b.x), bfhi(b.x), bflo(b.y), bfhi(b.y)} * rs * wv[2], o3 = (f32x4){bflo(b.z), bfhi(b.z), bflo(b.w), bfhi(b.w)} * rs * wv[3];
        if (!DRY || (o0[0] == 123.4567f && o1[1] == 7.654321f)) { row[2 * lane] = o0; row[2 * lane + 1] = o1; row[128 + 2 * lane] = o2; row[128 + 2 * lane + 1] = o3; }
    }
}
constexpr int N_PHASES = 13;
#ifndef DUP_FULL
#define DUP_FULL 0
#endif
#ifndef TAILRES_DUP
#define TAILRES_DUP 1
#endif
#ifndef FUSE_FINAL
#define FUSE_FINAL 1
#endif
#ifndef P8_PROBE
#define P8_PROBE 0
#endif
#ifndef TAIL_DUP
#define TAIL_DUP 1
#endif
#ifndef P12_DUP
#define P12_DUP 0
#endif
#ifndef PREP_PROBE_MODE
#define PREP_PROBE_MODE 0
#endif
__global__ void __launch_bounds__(512, 2) hybrid_fwd(Params P) {
    extern __shared__ __attribute__((aligned(16))) unsigned char lds_raw[];
    LAS unsigned char* lds = (LAS unsigned char*)lds_raw;
    const int tid = threadIdx.x, G = gridDim.x, bx = blockIdx.x;
    const int vcu = (G % 8 == 0) ? (bx % 8) * (G / 8) + bx / 8 : bx;
    volatile LAS unsigned* MISC = (volatile LAS unsigned*)(lds + LDS_MISC);
    if (tid < 64) MISC[tid] = 0u;
    __syncthreads();
    XcdBarrier bar = xcd_barrier_post((unsigned*)(P.ws + WS_CTL), MISC + 8);
    const int lo = P.ph_lo, hi = P.ph_hi;
#ifndef PH_MASK
#define PH_MASK 0x1fff
#endif
#define IN(k) ((((PH_MASK) >> (k)) & 1) && lo <= (k) && (k) < hi)
#ifndef DUP_BAR
#define DUP_BAR 1
#endif
#define SEAM(k) do { if (IN(k) && IN((k) + 1)) { for (int b_ = 0; b_ < DUP_BAR; ++b_) xcd_barrier(bar); } } while (0)
#ifndef DUP_MASK
#define DUP_MASK 0
#endif
#define NREP(k) ((((DUP_MASK) >> (k)) & 1) ? 2 : 1)
    bf16_t* Wb = (bf16_t*)(P.ws + WS_W);
    bf16_t* XB = (bf16_t*)(P.ws + WS_XB); bf16_t* BIG = (bf16_t*)(P.ws + WS_BIG); bf16_t* MIX = (bf16_t*)(P.ws + WS_MIX);
    float* SS = (float*)(P.ws + WS_SS);
    bf16_t* XB0 = (bf16_t*)P.out;

    if (IN(0)) for (int rep_ = 0; rep_ < NREP(0); ++rep_) { p0_prologue(P, lds, vcu, G); __syncthreads(); }
    SEAM(0);
    if (IN(1)) for (int rep_ = 0; rep_ < NREP(1); ++rep_) {
        pg8::Gemm g{XB0, Wb + W_IN, MP, NIN, D}; pg8::StaticOrder S; S.init(MP, NIN, G, bx);
        pg8::EpiScaleBf16 E{BIG, NIN, SS, DUP_FULL ? 0 : rep_};
        pg8::gemm_phase(lds, g, S, E);
        pg8::TailArgs t{XB0, Wb + W_IN, D, NIN, BIG, NIN, SS, nullptr, nullptr, nullptr, -1, {nullptr, nullptr}, {nullptr, nullptr}};
        if (rep_ == 0) for (int tr_ = 0; tr_ < TAIL_DUP; ++tr_) pg8::gemm_tail<pg8::TAIL_SCALE>(t, G);
    }
    SEAM(1);
    if (IN(2)) for (int rep_ = 0; rep_ < NREP(2); ++rep_) { if (rep_ == 0) gdn_prep_phase<0>(P, lds, bx, G); else gdn_prep_phase<PREP_PROBE_MODE>(P, lds, bx, G); }
    SEAM(2);
    if (IN(3)) for (int rep_ = 0; rep_ < NREP(3); ++rep_) {
        for (int u = bx; u < 256; u += G) {
#ifndef P3_PART
#define P3_PART 7
#endif
#ifndef PREP_PROBE_MODE
#define PREP_PROBE_MODE 0
#endif
#ifndef DUP_P3
#define DUP_P3 0
#endif
#ifndef SCAN_PROBE_MODE
#define SCAN_PROBE_MODE 0
#endif
#ifndef P3_SKIP
#define P3_SKIP 0
#endif
            if (u < 64) { if (!(P3_SKIP & 1)) for (int r2 = 0; r2 < ((DUP_P3 & 1) ? 2 : 1); ++r2) { if (r2 == 0) gdn_scan_block<0>(P, lds, u); else gdn_scan_block<SCAN_PROBE_MODE>(P, lds, u); __syncthreads(); } }
            else if (u < 192) { if (!(P3_SKIP & 2)) for (int r2 = 0; r2 < ((DUP_P3 & 2) ? 2 : 1); ++r2) { lru_block(P, lds, u - 64); __syncthreads(); } }
            else { if (!(P3_SKIP & 4)) for (int r2 = 0; r2 < ((DUP_P3 & 4) ? 2 : 1); ++r2) { sample_ab_block(P, lds, u - 192); __syncthreads(); } }
            __syncthreads();
        }
    }
    SEAM(3);
    if (IN(4)) for (int rep_ = 0; rep_ < NREP(4); ++rep_) {
        pg8::Gemm g{MIX, Wb + W_OUTAB, MP, D, D}; pg8::StaticOrder S; S.init(MP, D, G, bx);
        pg8::EpiResidual E{XB0, XB, SS + 1 * (size_t)MPAD, rep_, lds};
        pg8::gemm_phase(lds, g, S, E);
        pg8::TailArgs t{MIX, Wb + W_OUTAB, D, D, nullptr, 0, nullptr, XB0, XB, SS + 1 * (size_t)MPAD, -1, {(const f32x4*)P.in[I_CK], (const f32x4*)P.in[I_CV]}, {(f32x4*)(P.out + O_SSWAK), (f32x4*)(P.out + O_SSWAV)}};
        if (rep_ == 0) pg8::gemm_tail_res(t, G, lds);
    }
    SEAM(4);
    if (IN(5)) for (int rep_ = 0; rep_ < NREP(5); ++rep_) {
        pg8::Gemm g{XB, Wb + W_GU0, MP, NGU, D}; pg8::StaticOrder S; S.init(MP, NGU, G, bx);
        pg8::EpiSwiglu E{BIG, SS + 1 * (size_t)MPAD};
        pg8::gemm_phase(lds, g, S, E);
        pg8::TailArgs t{XB, Wb + W_GU0, D, FF, BIG, FF, SS + 1 * (size_t)MPAD, nullptr, nullptr, nullptr, -1, {nullptr, nullptr}, {nullptr, nullptr}};
        for (int tr_ = 0; tr_ < TAIL_DUP; ++tr_) pg8::gemm_tail<pg8::TAIL_SWIGLU>(t, G);
    }
    SEAM(5);
    if (IN(6)) for (int rep_ = 0; rep_ < NREP(6); ++rep_) {
        pg8::Gemm g{BIG, Wb + W_DN0, MP, D, FF}; pg8::StaticOrder S; S.init(MP, D, G, bx);
        pg8::EpiResidual E{XB, XB, SS + 2 * (size_t)MPAD, rep_, lds};
        pg8::gemm_phase(lds, g, S, E);
        pg8::TailArgs t{BIG, Wb + W_DN0, FF, D, nullptr, 0, nullptr, XB, XB, SS + 2 * (size_t)MPAD, -1, {(const f32x4*)P.in[I_CK], (const f32x4*)P.in[I_CV]}, {(f32x4*)(P.out + O_SSWAK), (f32x4*)(P.out + O_SSWAV)}};
        if (rep_ == 0) pg8::gemm_tail_res(t, G, lds);
    }
    SEAM(6);
    if (IN(7)) {
        pg8::Gemm g{XB, Wb + W_QKV, MP, NQKV, D}; pg8::StaticOrder S; S.init(MP, NQKV, G, bx);
        pg8::EpiScaleBf16 E{BIG, NQKV, SS + 2 * (size_t)MPAD, 0};
        pg8::gemm_phase(lds, g, S, E);
        pg8::TailArgs t{XB, Wb + W_QKV, D, NQKV, BIG, NQKV, SS + 2 * (size_t)MPAD, nullptr, nullptr, nullptr, -1, {nullptr, nullptr}, {nullptr, nullptr}};
        for (int tr_ = 0; tr_ < TAIL_DUP; ++tr_) pg8::gemm_tail<pg8::TAIL_SCALE>(t, G);
    }
    SEAM(7);
    if (IN(8)) for (int rep_ = 0; rep_ < NREP(8); ++rep_) {
#ifndef P8_PART
#define P8_PART 3
#endif
        if (G == 256) {
#ifndef P8_SPLIT
#define P8_SPLIT 3
#endif
            if (rep_ == 0) {
            if (bx < NS) { attn_sample_item(P, lds, bx); attn_prompt_run<0>(P, lds, P8_SPLIT * bx, P8_SPLIT); }
            else { attn_prompt_run<0>(P, lds, 128 * P8_SPLIT + (8 - P8_SPLIT) * (bx - NS), 8 - P8_SPLIT); }
            } else {
            if (bx < NS) { if (!(P8_PROBE & 16)) attn_sample_item(P, lds, bx); attn_prompt_run<(P8_PROBE & 15)>(P, lds, P8_SPLIT * bx, P8_SPLIT); }
            else { attn_prompt_run<(P8_PROBE & 15)>(P, lds, 128 * P8_SPLIT + (8 - P8_SPLIT) * (bx - NS), 8 - P8_SPLIT); }
            }
        } else {
            for (int s = bx; s < NS; s += G) attn_sample_item(P, lds, s);
            for (int it = bx; it < 1024; it += G) attn_prompt_run<0>(P, lds, it, 1);
        }
    }
    SEAM(8);
    if (IN(9)) for (int rep_ = 0; rep_ < NREP(9); ++rep_) {
        if (FUSE_FINAL) { unsigned long long* sl_ = (unsigned long long*)(P.ws + WS_BA); for (int i = bx * 512 + tid; i < 128 * 1024; i += G * 512) sl_[i] = 0ull; }
        pg8::Gemm g{MIX, Wb + W_OUTC, MP, D, D}; pg8::StaticOrder S; S.init(MP, D, G, bx);
        pg8::EpiResidual E{XB, XB, SS + 3 * (size_t)MPAD, rep_, lds};
        pg8::gemm_phase(lds, g, S, E);
        pg8::TailArgs t{MIX, Wb + W_OUTC, D, D, nullptr, 0, nullptr, XB, XB, SS + 3 * (size_t)MPAD, -1, {(const f32x4*)P.in[I_CK], (const f32x4*)P.in[I_CV]}, {(f32x4*)(P.out + O_SSWAK), (f32x4*)(P.out + O_SSWAV)}};
        if (rep_ == 0) pg8::gemm_tail_res(t, G, lds);
    }
    SEAM(9);
    if (IN(10)) {
        pg8::Gemm g{XB, Wb + W_GU1, MP, NGU, D}; pg8::StaticOrder S; S.init(MP, NGU, G, bx);
        pg8::EpiSwiglu E{BIG, SS + 3 * (size_t)MPAD};
        pg8::gemm_phase(lds, g, S, E);
        pg8::TailArgs t{XB, Wb + W_GU1, D, FF, BIG, FF, SS + 3 * (size_t)MPAD, nullptr, nullptr, nullptr, -1, {nullptr, nullptr}, {nullptr, nullptr}};
        for (int tr_ = 0; tr_ < TAIL_DUP; ++tr_) pg8::gemm_tail<pg8::TAIL_SWIGLU>(t, G);
    }
    SEAM(10);
    if (IN(11)) {
        pg8::Gemm g{BIG, Wb + W_DN1, MP, D, FF}; pg8::StaticOrder S; S.init(MP, D, G, bx);
        if (FUSE_FINAL && G == 256) { pg8::EpiResidualFinal E{XB, P.out, P.in[I_NFIN], (unsigned long long*)(P.ws + WS_BA), lds}; pg8::gemm_phase(lds, g, S, E); }
        else { pg8::EpiResidual E{XB, XB, SS + 4 * (size_t)MPAD, 0, lds}; pg8::gemm_phase(lds, g, S, E); }
        pg8::TailArgs t{BIG, Wb + W_DN1, FF, D, nullptr, 0, nullptr, XB, XB, SS + 4 * (size_t)MPAD, -1, {(const f32x4*)P.in[I_CK], (const f32x4*)P.in[I_CV]}, {(f32x4*)(P.out + O_SSWAK), (f32x4*)(P.out + O_SSWAV)}};
        pg8::gemm_tail_res(t, G, lds);
    }
    SEAM(11);
    if (IN(12)) final_norm<0>(P, vcu, G, (FUSE_FINAL && G == 256) ? MP : 0);
#undef IN
#undef SEAM
}

#ifndef MK_N_LAUNCHES
#define MK_N_LAUNCHES 1
#endif
extern "C" void kernel_launch(void* const* d_in, const int* in_sizes, int n_in, void* d_out, int out_size, void* d_ws, size_t ws_size, hipStream_t stream) {
    static int grid = 0;
    if (grid == 0) {
        if (n_in != 29 || out_size != (int)O_END || ws_size < WS_END) { fprintf(stderr, "kernel_launch: unexpected shapes: n_in %d out %d ws %zu (need %zu)\n", n_in, out_size, ws_size, (size_t)WS_END); grid = -1; return; }
        int dev = 0, cus = 0;
        if (hipGetDevice(&dev) != hipSuccess || hipDeviceGetAttribute(&cus, hipDeviceAttributeMultiprocessorCount, dev) != hipSuccess) { grid = -1; return; }
        if (hipFuncSetAttribute((const void*)hybrid_fwd, hipFuncAttributeMaxDynamicSharedMemorySize, LDS_BYTES) != hipSuccess) { fprintf(stderr, "kernel_launch: hipFuncSetAttribute failed\n"); grid = -1; return; }
        int per_cu = 0;
        if (hipOccupancyMaxActiveBlocksPerMultiprocessor(&per_cu, (const void*)hybrid_fwd, 512, LDS_BYTES) != hipSuccess || per_cu < 1) fprintf(stderr, "kernel_launch: occupancy query says %d blocks per CU\n", per_cu);
        (void)hipGetLastError();
        grid = cus;
    }
    if (grid < 0) return;
    Params p{};
    for (int i = 0; i < 29; ++i) p.in[i] = (const float*)d_in[i];
    p.out = (float*)d_out; p.ws = (unsigned char*)d_ws;
    if (MK_N_LAUNCHES == 1) {
        (void)hipMemsetAsync((char*)d_ws + WS_CTL, 0, CTL_BYTES, stream);
        p.ph_lo = 0; p.ph_hi = N_PHASES;
        hipLaunchKernelGGL(hybrid_fwd, dim3(grid), dim3(512), LDS_BYTES, stream, p);
    } else {
        (void)hipMemsetAsync((char*)d_ws + WS_CTL, 0, CTL_BYTES, stream);
        for (int ph = 0; ph < N_PHASES; ++ph) { p.ph_lo = ph; p.ph_hi = ph + 1; hipLaunchKernelGGL(hybrid_fwd, dim3(grid), dim3(512), LDS_BYTES, stream, p); }
    }
    const hipError_t le = hipPeekAtLastError();
    if (le != hipSuccess) fprintf(stderr, "kernel_launch: launch failed: %s\n", hipGetErrorName(le));
}
```
